# Optimizing an MI355X kernel written in HIP

```python
import jax, jax.numpy as jnp
from jax import lax
import numpy as np


D_MODEL = 1024
BATCH = 8
SEQ = 2048
DEPTH = 1

GLA_HEADS = 4
GLA_DK = 64
GLA_DV = 128
GLA_WIDTH = GLA_HEADS * GLA_DV
GLA_GATE_RANK = 16
GLA_GATE_NORM = 16.0
GDN_HEADS = 4
GDN_DK = 128
GDN_DV = 128
GDN_WIDTH = GDN_HEADS * GDN_DV
CONV_W = 4
CHUNK = 64
N_GROUPS = 8
EXPERTS_PER_GROUP = 8
N_EXPERTS = N_GROUPS * EXPERTS_PER_GROUP
TOP_K = 2
D_EXPERT = 512
DISPATCH_BLOCK = 128
LN_EPS = 1e-5
RMS_EPS = 1e-6
ALPHA_DN = (2.0 * DEPTH) ** 0.25
BETA_DN = (8.0 * DEPTH) ** -0.25

_SEG_SIZES = (GLA_HEADS * GLA_DK, GLA_HEADS * GLA_DK, GLA_WIDTH, GLA_WIDTH, GLA_GATE_RANK,
              GDN_HEADS * GDN_DK, GDN_HEADS * GDN_DK, GDN_WIDTH, GDN_WIDTH, GDN_HEADS, GDN_HEADS)
IN_PROJ_DIM = sum(_SEG_SIZES)
CONV_CH = 2 * GDN_HEADS * GDN_DK + GDN_WIDTH

kernel_name = 'hybrid_gla_gdn_hmoe_deepnorm'


def _layer_norm(x, g, b):
    xf = x.astype(jnp.float32)
    mu = jnp.mean(xf, axis=-1, keepdims=True)
    var = jnp.mean(jnp.square(xf - mu), axis=-1, keepdims=True)
    return ((xf - mu) * lax.rsqrt(var + LN_EPS) * g.astype(jnp.float32) + b.astype(jnp.float32)).astype(x.dtype)


def _rms_norm(x, g):
    return x * lax.rsqrt(jnp.mean(jnp.square(x), axis=-1, keepdims=True) + RMS_EPS) * g.astype(jnp.float32)


def _l2_norm(x):
    return x * lax.rsqrt(jnp.sum(jnp.square(x), axis=-1, keepdims=True) + RMS_EPS)


def _to_chunks(t, heads):
    b, s, w = t.shape
    return t.reshape(b, s // CHUNK, CHUNK, heads, w // heads).transpose(1, 0, 3, 2, 4)


def _to_chunks_scalar(t):
    b, s, h = t.shape
    return t.reshape(b, s // CHUNK, CHUNK, h).transpose(1, 0, 3, 2)


def _from_chunks(t):
    nc, b, h, c, d = t.shape
    return t.transpose(1, 0, 3, 2, 4).reshape(b, nc * c, h, d)


def _causal_conv(x, w):
    c = x.shape[-1]
    return lax.conv_general_dilated(x, w[:, None, :], window_strides=(1,), padding=[(CONV_W - 1, 0)],
                                    dimension_numbers=('NWC', 'WIO', 'NWC'), feature_group_count=c)


def _gla_chunked(q, k, v, g):
    nc, bsz, nh, c, dk = q.shape
    dv = v.shape[-1]
    causal = jnp.tril(jnp.ones((c, c), dtype=bool))

    def step(state, inp):
        qc, kc, vc, gc = inp
        b = jnp.cumsum(gc, axis=-2)
        rel = jnp.exp(jnp.where(causal[:, :, None], b[..., :, None, :] - b[..., None, :, :], -jnp.inf))
        attn = jnp.einsum('bhid,bhjd,bhijd->bhij', qc, kc, rel)
        o = jnp.einsum('bhid,bhde->bhie', qc * jnp.exp(b), state) + jnp.einsum('bhij,bhje->bhie', attn, vc)
        b_last = b[..., -1:, :]
        state = jnp.exp(b_last[..., 0, :])[..., None] * state + jnp.einsum('bhjd,bhje->bhde', kc * jnp.exp(b_last - b), vc)
        return state, o

    s0 = jnp.zeros((bsz, nh, dk, dv), q.dtype)
    _, o = lax.scan(step, s0, (q, k, v, g))
    return o


def _gdn_chunked(q, k, v, beta, g):
    c = q.shape[-2]
    dv = v.shape[-1]
    causal = jnp.tril(jnp.ones((c, c), dtype=bool))
    strict = jnp.tril(jnp.ones((c, c), dtype=bool), -1)
    eye = jnp.eye(c, dtype=q.dtype)
    gam = jnp.cumsum(g, axis=-1)
    decay = jnp.exp(jnp.where(causal, gam[..., :, None] - gam[..., None, :], -jnp.inf))
    a_mat = jnp.where(strict, beta[..., :, None] * jnp.einsum('nbhid,nbhjd->nbhij', k, k) * decay, 0.0)
    rhs = jnp.concatenate([beta[..., None] * v, beta[..., None] * k * jnp.exp(gam)[..., None]], axis=-1)
    uw = lax.linalg.triangular_solve(eye + a_mat, rhs, left_side=True, lower=True, unit_diagonal=True)
    u, w = uw[..., :dv], uw[..., dv:]
    attn = jnp.einsum('nbhid,nbhjd->nbhij', q, k) * decay
    q_dec = q * jnp.exp(gam)[..., None]
    gam_last = gam[..., -1:]
    k_dec = k * jnp.exp(gam_last - gam)[..., None]
    chunk_decay = jnp.exp(gam_last[..., 0])

    def step(state, inp):
        qd, at, uc, wc, kd, dl = inp
        v_new = uc - jnp.einsum('bhid,bhde->bhie', wc, state)
        o = jnp.einsum('bhid,bhde->bhie', qd, state) + jnp.einsum('bhij,bhje->bhie', at, v_new)
        state = dl[..., None, None] * state + jnp.einsum('bhjd,bhje->bhde', kd, v_new)
        return state, o

    nc, bsz, nh, _, dk = q.shape
    s0 = jnp.zeros((bsz, nh, dk, dv), q.dtype)
    _, o = lax.scan(step, s0, (q_dec, attn, u, w, k_dec, chunk_decay))
    return o


def _mixer(h, w_in, w_gk_up, b_gk, conv_w, a_log, dt_bias, gla_norm_g, gdn_norm_g, w_out):
    f32 = jnp.float32
    bsz, seq, _ = h.shape
    proj = (h @ w_in).astype(f32)
    qa, ka, va, ra, lra, qb, kb, vb, zb, bb, ab = jnp.split(proj, np.cumsum(_SEG_SIZES)[:-1].tolist(), axis=-1)
    gk = jax.nn.log_sigmoid(lra @ w_gk_up.astype(f32) + b_gk.astype(f32)) / GLA_GATE_NORM
    o_a = _gla_chunked(_to_chunks(qa * GLA_DK ** -0.5, GLA_HEADS), _to_chunks(ka, GLA_HEADS),
                       _to_chunks(va, GLA_HEADS), _to_chunks(gk, GLA_HEADS))
    o_a = _rms_norm(_from_chunks(o_a), gla_norm_g) * jax.nn.silu(ra.reshape(bsz, seq, GLA_HEADS, GLA_DV))
    qkv = jax.nn.silu(_causal_conv(jnp.concatenate([qb, kb, vb], axis=-1), conv_w.astype(f32)))
    qb, kb, vb = jnp.split(qkv, [GDN_HEADS * GDN_DK, 2 * GDN_HEADS * GDN_DK], axis=-1)
    qb = _l2_norm(_to_chunks(qb, GDN_HEADS)) * GDN_DK ** -0.5
    kb = _l2_norm(_to_chunks(kb, GDN_HEADS))
    beta = _to_chunks_scalar(jax.nn.sigmoid(bb))
    g_b = _to_chunks_scalar(-jnp.exp(a_log.astype(f32)) * jax.nn.softplus(ab + dt_bias.astype(f32)))
    o_b = _gdn_chunked(qb, kb, _to_chunks(vb, GDN_HEADS), beta, g_b)
    o_b = _rms_norm(_from_chunks(o_b), gdn_norm_g) * jax.nn.silu(zb.reshape(bsz, seq, GDN_HEADS, GDN_DV))
    mixed = jnp.concatenate([o_a.reshape(bsz, seq, GLA_WIDTH), o_b.reshape(bsz, seq, GDN_WIDTH)], axis=-1)
    return (mixed @ w_out.astype(f32)).astype(h.dtype)


def _moe(h, w_router_group, b_router_group, w_router_expert, b_router_expert, w_gate, w_up, w_down):
    f32 = jnp.float32
    bsz, seq, d = h.shape
    n = bsz * seq
    xt = h.reshape(n, d)
    xf = xt.astype(f32)
    group_prob = jax.nn.softmax(xf @ w_router_group.astype(f32) + b_router_group.astype(f32), axis=-1)
    p_group, g_sel = lax.top_k(group_prob, 1)
    g_sel = g_sel[:, 0]
    e_logits = (xf @ w_router_expert.astype(f32) + b_router_expert.astype(f32)).reshape(n, N_GROUPS, EXPERTS_PER_GROUP)
    e_logits = e_logits[jnp.arange(n), g_sel]
    top_logit, top_e = lax.top_k(e_logits, TOP_K)
    gate = p_group * jax.nn.softmax(top_logit, axis=-1)
    expert_id = (g_sel[:, None] * EXPERTS_PER_GROUP + top_e).reshape(-1)
    n_assign = n * TOP_K
    tok = jnp.arange(n_assign, dtype=jnp.int32) // TOP_K
    order = jnp.argsort(expert_id)
    e_sorted = expert_id[order]
    counts = jnp.bincount(expert_id, length=N_EXPERTS)
    starts = jnp.cumsum(counts) - counts
    padded = (counts + DISPATCH_BLOCK - 1) // DISPATCH_BLOCK * DISPATCH_BLOCK
    pends = jnp.cumsum(padded)
    pstarts = pends - padded
    dest_sorted = pstarts[e_sorted] + jnp.arange(n_assign, dtype=jnp.int32) - starts[e_sorted]
    dest = jnp.zeros((n_assign,), jnp.int32).at[order].set(dest_sorted.astype(jnp.int32))
    n_blocks = -(-n_assign // DISPATCH_BLOCK) + N_EXPERTS
    buf_tok = jnp.full((n_blocks * DISPATCH_BLOCK,), n, dtype=jnp.int32).at[dest].set(tok)
    x_pad = jnp.concatenate([xt, jnp.zeros((1, d), xt.dtype)], axis=0)
    xbuf = x_pad[buf_tok].reshape(n_blocks, DISPATCH_BLOCK, d)
    blk_expert = jnp.minimum(jnp.searchsorted(pends, jnp.arange(n_blocks) * DISPATCH_BLOCK, side='right'), N_EXPERTS - 1)

    def expert_block(blk):
        xb, e = blk
        hid = jax.nn.silu(xb @ w_gate[e]) * (xb @ w_up[e])
        return hid @ w_down[e]

    ybuf = lax.map(expert_block, (xbuf, blk_expert)).reshape(n_blocks * DISPATCH_BLOCK, d)
    y_assign = ybuf[dest].reshape(n, TOP_K, d)
    y = jnp.einsum('nkd,nk->nd', y_assign, gate.astype(y_assign.dtype))
    return y.reshape(bsz, seq, d).astype(h.dtype)


def setup_inputs(seed: int = 0) -> dict:
    key = jax.random.key(seed)
    ks = jax.random.split(key, 24)
    f32 = jnp.float32
    L = DEPTH

    def nrm(k, shape, scale):
        return jax.random.normal(k, shape, f32) * scale

    x = nrm(ks[0], (BATCH, SEQ, D_MODEL), 1.0)
    w_in = nrm(ks[1], (L, D_MODEL, IN_PROJ_DIM), D_MODEL ** -0.5)
    w_gk_up = nrm(ks[2], (L, GLA_GATE_RANK, GLA_HEADS * GLA_DK), GLA_GATE_RANK ** -0.5)
    b_gk = nrm(ks[3], (L, GLA_HEADS * GLA_DK), 0.1)
    conv_w = nrm(ks[4], (L, CONV_W, CONV_CH), CONV_W ** -0.5)
    a_log = jnp.log(jax.random.uniform(ks[5], (L, GDN_HEADS), f32, minval=1.0, maxval=16.0))
    dt = jnp.exp(jax.random.uniform(ks[6], (L, GDN_HEADS), f32, minval=float(np.log(1e-3)), maxval=float(np.log(1e-1))))
    dt_bias = dt + jnp.log(-jnp.expm1(-dt))
    gla_norm_g = 1.0 + nrm(ks[7], (L, GLA_DV), 0.02)
    gdn_norm_g = 1.0 + nrm(ks[8], (L, GDN_DV), 0.02)
    w_out = nrm(ks[9], (L, GLA_WIDTH + GDN_WIDTH, D_MODEL), (GLA_WIDTH + GDN_WIDTH) ** -0.5 * BETA_DN)
    ln1_g = 1.0 + nrm(ks[10], (L, D_MODEL), 0.02)
    ln1_b = nrm(ks[11], (L, D_MODEL), 0.02)
    w_router_group = nrm(ks[12], (L, D_MODEL, N_GROUPS), D_MODEL ** -0.5)
    b_router_group = nrm(ks[13], (L, N_GROUPS), 0.01)
    w_router_expert = nrm(ks[14], (L, D_MODEL, N_EXPERTS), D_MODEL ** -0.5)
    b_router_expert = nrm(ks[15], (L, N_EXPERTS), 0.01)
    w_gate = nrm(ks[16], (L, N_EXPERTS, D_MODEL, D_EXPERT), D_MODEL ** -0.5)
    w_up = nrm(ks[17], (L, N_EXPERTS, D_MODEL, D_EXPERT), D_MODEL ** -0.5)
    w_down = nrm(ks[18], (L, N_EXPERTS, D_EXPERT, D_MODEL), D_EXPERT ** -0.5 * BETA_DN)
    ln2_g = 1.0 + nrm(ks[19], (L, D_MODEL), 0.02)
    ln2_b = nrm(ks[20], (L, D_MODEL), 0.02)
    return {'x': x, 'w_in': w_in, 'w_gk_up': w_gk_up, 'b_gk': b_gk, 'conv_w': conv_w,
            'a_log': a_log, 'dt_bias': dt_bias, 'gla_norm_g': gla_norm_g, 'gdn_norm_g': gdn_norm_g,
            'w_out': w_out, 'ln1_g': ln1_g, 'ln1_b': ln1_b,
            'w_router_group': w_router_group, 'b_router_group': b_router_group,
            'w_router_expert': w_router_expert, 'b_router_expert': b_router_expert,
            'w_gate': w_gate, 'w_up': w_up, 'w_down': w_down, 'ln2_g': ln2_g, 'ln2_b': ln2_b}


def reference(x, w_in, w_gk_up, b_gk, conv_w, a_log, dt_bias, gla_norm_g, gdn_norm_g, w_out,
              ln1_g, ln1_b, w_router_group, b_router_group, w_router_expert, b_router_expert,
              w_gate, w_up, w_down, ln2_g, ln2_b):
    for l in range(DEPTH):
        y = _mixer(x, w_in[l], w_gk_up[l], b_gk[l], conv_w[l], a_log[l], dt_bias[l],
                   gla_norm_g[l], gdn_norm_g[l], w_out[l])
        x = _layer_norm(ALPHA_DN * x + y, ln1_g[l], ln1_b[l])
        y = _moe(x, w_router_group[l], b_router_group[l], w_router_expert[l], b_router_expert[l],
                 w_gate[l], w_up[l], w_down[l])
        x = _layer_norm(ALPHA_DN * x + y, ln2_g[l], ln2_b[l])
    return x
```

```cpp
#include <hip/hip_runtime.h>
#include <stdint.h>
#include <stdio.h>
#include <type_traits>

#ifndef MK_N_LAUNCHES
#define MK_N_LAUNCHES 1
#endif

#ifndef REPEAT_PHASE
#define REPEAT_PHASE (-1)
#endif

#define DI __device__ __forceinline__
typedef unsigned short u16;
using bf16x8 = __attribute__((ext_vector_type(8))) __bf16;
using f32x16 = __attribute__((ext_vector_type(16))) float;
using f32x4  = __attribute__((ext_vector_type(4))) float;
using u32x4  = __attribute__((ext_vector_type(4))) unsigned;

constexpr int NTOK = 16384, DM = 1024, SEQ = 2048, NCH = 32;
constexpr int PLD = 3584;
constexpr int C_QA = 0, C_KA = 256, C_VA = 512, C_RA = 1024, C_QB = 1536, C_KB = 2048, C_VB = 2560, C_ZB = 3072;
constexpr int WIN_LD = 3608;
constexpr float ALPHA = 1.189207115002721f;
constexpr int NPHASE = 9;

constexpr size_t MB = 1024 * 1024;
constexpr size_t WS_BAR = 0;
constexpr size_t WS_CNT = 16384;
constexpr size_t WS_WRT = 32768;
constexpr size_t WS_SMALL = 512 * 1024;
constexpr size_t WS_DL = 3 * MB;
constexpr size_t WS_PROJ = 4 * MB;
constexpr size_t WS_YS = 4 * MB;
constexpr size_t WS_X1F = 68 * MB;
constexpr size_t WS_GDN = 116 * MB;
constexpr size_t GDN_UNIT = 73728;
constexpr size_t WS_HBUF = 132 * MB;
constexpr size_t WS_GLA = 188 * MB;
constexpr size_t GLA_UNIT = 24832;
constexpr size_t WS_H = 196 * MB;
constexpr size_t WS_MIXED = 214 * MB;
constexpr size_t WS_WGU = 246 * MB;
constexpr size_t WS_WD = 374 * MB;
constexpr size_t WS_XB = 438 * MB;
constexpr size_t WS_X1B = 438 * MB;
constexpr size_t WS_WINT = 470 * MB;
constexpr size_t WS_WOUTT = 478 * MB;
constexpr size_t WS_LTOK = 480 * MB;
constexpr size_t WS_LGATE = 484 * MB;
constexpr size_t WS_END = 488 * MB;

constexpr int LDS_BYTES = 155648;

struct Params {
    const float *x, *w_in, *w_gk_up, *b_gk, *conv_w, *a_log, *dt_bias, *gla_g, *gdn_g, *w_out, *ln1_g, *ln1_b;
    const float *w_rg, *b_rg, *w_re, *b_re, *w_gate, *w_up, *w_down, *ln2_g, *ln2_b;
    float* out;
    unsigned char* ws;
    int ph_lo, ph_hi;
};

DI u16 f2bf(float x) { return __builtin_bit_cast(u16, (__bf16)x); }
DI float bf2f(u16 v) { return __uint_as_float(((unsigned)v) << 16); }
typedef __bf16 bf16x2_t __attribute__((ext_vector_type(2)));
typedef float f32x2_t __attribute__((ext_vector_type(2)));
typedef unsigned u32x2_t __attribute__((ext_vector_type(2)));
DI unsigned pack2(float a, float b) { const f32x2_t v = {a, b}; return __builtin_bit_cast(unsigned, __builtin_convertvector(v, bf16x2_t)); }
DI float bflo(unsigned v) { return __uint_as_float(v << 16); }
DI float bfhi(unsigned v) { return __uint_as_float(v & 0xffff0000u); }
DI int crow(int i, int h) { return (i & 3) + 8 * (i >> 2) + 4 * h; }
DI float silu_f(float x) { return x / (1.f + __expf(-x)); }
DI f32x16 mfma32(bf16x8 a, bf16x8 b, f32x16 c) { return __builtin_amdgcn_mfma_f32_32x32x16_bf16(a, b, c, 0, 0, 0); }
DI f32x4 mfma16(bf16x8 a, bf16x8 b, f32x4 c) { return __builtin_amdgcn_mfma_f32_16x16x32_bf16(a, b, c, 0, 0, 0); }
DI bf16x8 ld_frag(const char* p) { return __builtin_bit_cast(bf16x8, *(const u32x4*)p); }
DI bf16x8 ld_frag_perm(const char* rowp, int ks, int h) {
    const char* p = rowp + (16 * ks + 4 * h) * 2;
    uint2 lo = *(const uint2*)p, hi = *(const uint2*)(p + 16);
    u32x4 v = {lo.x, lo.y, hi.x, hi.y};
    return __builtin_bit_cast(bf16x8, v);
}
template <int N, int I = 0, class F> DI void static_for(F&& f) {
    if constexpr (I < N) { f(std::integral_constant<int, I>{}); static_for<N, I + 1>(f); }
}
DI bf16x8 ld_frag2(const char* p) {
    const uint2 lo = *(const uint2*)p, hi = *(const uint2*)(p + 16);
    const u32x4 v = {lo.x, lo.y, hi.x, hi.y};
    return __builtin_bit_cast(bf16x8, v);
}
template <int S> DI bf16x8 pack8(const f32x16& x) {
    u32x4 v = {pack2(x[8 * S], x[8 * S + 1]), pack2(x[8 * S + 2], x[8 * S + 3]), pack2(x[8 * S + 4], x[8 * S + 5]), pack2(x[8 * S + 6], x[8 * S + 7])};
    return __builtin_bit_cast(bf16x8, v);
}
DI float dpp_row_shr(float v, int n) {
    const int iv = __builtin_bit_cast(int, v); int r;
    switch (n) { case 1: r = __builtin_amdgcn_update_dpp(0, iv, 0x111, 0xf, 0xf, true); break; case 2: r = __builtin_amdgcn_update_dpp(0, iv, 0x112, 0xf, 0xf, true); break;
                 case 4: r = __builtin_amdgcn_update_dpp(0, iv, 0x114, 0xf, 0xf, true); break; default: r = __builtin_amdgcn_update_dpp(0, iv, 0x118, 0xf, 0xf, true); break; }
    return __builtin_bit_cast(float, r);
}
DI float wave_scan_incl(float v) {
    v += dpp_row_shr(v, 1); v += dpp_row_shr(v, 2); v += dpp_row_shr(v, 4); v += dpp_row_shr(v, 8);
    v += __builtin_bit_cast(float, __builtin_amdgcn_update_dpp(0, __builtin_bit_cast(int, v), 0x142, 0xa, 0xf, false));
    v += __builtin_bit_cast(float, __builtin_amdgcn_update_dpp(0, __builtin_bit_cast(int, v), 0x143, 0xc, 0xf, false));
    return v;
}
DI uint4 ldnt_u4(const void* p) { const u32x4 v = __builtin_nontemporal_load((const u32x4*)p); return make_uint4(v.x, v.y, v.z, v.w); }
DI float4 ldnt4(const float* p) { const f32x4 v = __builtin_nontemporal_load((const f32x4*)p); return make_float4(v.x, v.y, v.z, v.w); }
DI void stnt4(float* p, float4 v) { __builtin_nontemporal_store(f32x4{v.x, v.y, v.z, v.w}, (f32x4*)p); }
DI float wave_sum(float v) {
#pragma unroll
    for (int o = 32; o > 0; o >>= 1) v += __shfl_xor(v, o, 64);
    return v;
}

#define XB_TMO      128
#define XB_XCNT(j)  (256  + 64 * (j))
#define XB_XSUB(j)  (1280 + 64 * (j))
#define XB_XGEN(j)  (2304 + 64 * (j))
#define XB_TOP      3328
#define XB_TOPGEN   3392
#define XCD_BAR_WORDS 3456
#define XB_SPIN_CAP (1u << 18)
#define LAS __attribute__((address_space(3)))

__device__ __forceinline__ unsigned xb_ld(unsigned* p)              { return __hip_atomic_load(p, __ATOMIC_RELAXED, __HIP_MEMORY_SCOPE_AGENT); }
__device__ __forceinline__ unsigned xb_add(unsigned* p, unsigned v) { return __hip_atomic_fetch_add(p, v, __ATOMIC_RELAXED, __HIP_MEMORY_SCOPE_AGENT); }
__device__ __forceinline__ unsigned xb_xcc_id() { return (unsigned)__builtin_amdgcn_s_getreg((3 << 11) | 20) & 0xFu; }
#define XB_SPIN(cond, bar) do { unsigned _sp = 0; while (cond) { __builtin_amdgcn_s_sleep(1); \
    if ((++_sp & 255u) == 0u) { if (xb_ld(&(bar)[XB_TMO])) break; if (_sp > XB_SPIN_CAP) { atomicAdd(&(bar)[XB_TMO], 1u); break; } } } } while (0)

struct XcdBarrier {
    unsigned* bar; unsigned x;
    volatile LAS unsigned* st;
};
__device__ __forceinline__ XcdBarrier xcd_barrier_post(unsigned* bar, volatile LAS unsigned* st) {
    XcdBarrier b; b.bar = bar; b.x = xb_xcc_id(); b.st = st;
    if (threadIdx.x == 0) (void)xb_add(&bar[XB_XCNT(b.x)], 1u);
    return b;
}
__device__ __forceinline__ void xcd_barrier_complete(unsigned* bar, unsigned x, unsigned& nloc, unsigned& nx) {
    const unsigned G = gridDim.x * gridDim.y * gridDim.z;
    unsigned sum, cnt, mine, sp = 0u;
    for (;;) {
        sum = 0u; cnt = 0u; mine = 0u;
#pragma unroll
        for (unsigned j = 0; j < 16; ++j) { const unsigned c = xb_ld(&bar[XB_XCNT(j)]); sum += c; cnt += (c > 0u) ? 1u : 0u; mine = (j == x) ? c : mine; }
        if (sum == G) break;
        __builtin_amdgcn_s_sleep(1);
        if ((++sp & 255u) == 0u) { if (xb_ld(&bar[XB_TMO])) break; if (sp > XB_SPIN_CAP) { atomicAdd(&bar[XB_TMO], 1u); break; } }
    }
    nloc = mine > 0u ? mine : 1u; nx = cnt > 0u ? cnt : 1u;
}
__device__ __forceinline__ void xcd_barrier(const XcdBarrier& b) {
    asm volatile("s_waitcnt vmcnt(0)" ::: "memory");
    __syncthreads();
    if (threadIdx.x == 0) {
        unsigned* bar = b.bar;
        __builtin_amdgcn_s_waitcnt(0);
        unsigned nloc = b.st[0], nx = b.st[1];
        if (nloc == 0u) { xcd_barrier_complete(bar, b.x, nloc, nx); b.st[0] = nloc; b.st[1] = nx; }
        const unsigned old = xb_add(&bar[XB_XSUB(b.x)], 1u);
        const unsigned gen = old / nloc;
        if (old + 1u == (gen + 1u) * nloc) {
            __builtin_amdgcn_fence(__ATOMIC_RELEASE, "agent");
            asm volatile("s_waitcnt vmcnt(0)" ::: "memory");
            const unsigned og = xb_add(&bar[XB_TOP], 1u);
            const unsigned tg = og / nx;
            if (og + 1u == (tg + 1u) * nx) xb_add(&bar[XB_TOPGEN], 1u);
            else XB_SPIN(xb_ld(&bar[XB_TOPGEN]) == tg, bar);
            __builtin_amdgcn_fence(__ATOMIC_ACQUIRE, "agent");
            xb_add(&bar[XB_XGEN(b.x)], 1u);
            asm volatile("s_waitcnt vmcnt(0)" ::: "memory");
        } else {
            XB_SPIN(xb_ld(&bar[XB_XGEN(b.x)]) == gen, bar);
            __builtin_amdgcn_fence(__ATOMIC_ACQUIRE, "agent");
            asm volatile("s_waitcnt vmcnt(0)" ::: "memory");
        }
    }
    __syncthreads();
}

namespace pg {
typedef float f32x4 __attribute__((ext_vector_type(4)));
typedef short s16x8 __attribute__((ext_vector_type(8)));
constexpr int BK = 64, HALF = 128, HTB = HALF * BK * 2, STAGE_BYTES = 8 * HTB;
DI int lds_byte(int r, int c) { const int st = (r >> 4) * 2 + (c >> 5), rr = r & 15, cc = c & 31, ob = rr * 64 + cc * 2; return st * 1024 + (ob ^ (((ob >> 9) & 1) << 5)); }
DI void stage_rc(int b, int& R, int& C) { const int st = b / 1024, sb = b % 1024, swz = sb ^ (((sb >> 9) & 1) << 5); R = (st >> 1) * 16 + swz / 64; C = (st & 1) * 32 + (swz % 64) / 2; }
DI int perm32(int rho) { const int n = rho >> 4, i = rho & 15; return 8 * (i >> 2) + 4 * n + (i & 3); }

template <class Epi, class Sched>
DI void gemm_phase(LAS unsigned char* lds, const Sched& S, const Epi& E, const int K) {
    const int tid = threadIdx.x, wid = __builtin_amdgcn_readfirstlane(tid >> 6), lane = tid & 63, wr = wid >> 2, wc = wid & 3, fr = lane & 15, fq = lane >> 4;
    const int nt = K / BK;
    int RA[2], CA[2]; unsigned voffB[2];
#pragma unroll
    for (int i = 0; i < 2; ++i) { int R, C; stage_rc(tid * 16 + i * 8192, R, C); RA[i] = R; CA[i] = C; const int Rb = (R & ~31) + perm32(R & 31); voffB[i] = (unsigned)(Rb * K + C) * 2u; }
    const size_t kstep = (size_t)(BK * 2);
    const size_t hstepB = (size_t)HALF * K * 2;
    const unsigned ldsw = (unsigned)wid * 1024u;
    const int aoff = lds_byte(wr * 64 + fr, fq * 8), boff = lds_byte(wc * 32 + fr, fq * 8);
#define PG_SA(b, h) (((b) * 2 + (h)) * HTB)
#define PG_SB(b, h) ((4 + (b) * 2 + (h)) * HTB)
#define PG_STAGE(bufoff, gbase, voff) do { _Pragma("unroll") for (int _i = 0; _i < 2; ++_i) \
        __builtin_amdgcn_global_load_lds((const unsigned*)((const char*)(gbase) + (voff)[_i]), (LAS unsigned*)(lds + (bufoff) + ldsw + _i * 8192), 16, 0, 0); } while (0)
#define PG_LDA(dst, b, h) do { _Pragma("unroll") for (int m = 0; m < 4; ++m) _Pragma("unroll") for (int k = 0; k < 2; ++k) dst[m][k] = *(const LAS s16x8*)(lds + PG_SA(b, h) + aoff + m * 2048 + k * 1024); } while (0)
#define PG_LDB(dst, b, h) do { _Pragma("unroll") for (int n = 0; n < 2; ++n) _Pragma("unroll") for (int k = 0; k < 2; ++k) dst[n][k] = *(const LAS s16x8*)(lds + PG_SB(b, h) + boff + n * 2048 + k * 1024); } while (0)
#define PG_MMA(ai, bj, At, Bt) do { if ((ai) == 1 && skip1) break; __builtin_amdgcn_s_setprio(1); _Pragma("unroll") for (int m = 0; m < 4; ++m) _Pragma("unroll") for (int n = 0; n < 2; ++n) _Pragma("unroll") for (int k = 0; k < 2; ++k) \
        acc[ai][bj][m][n] = __builtin_amdgcn_mfma_f32_16x16x32_bf16(__builtin_bit_cast(bf16x8, Bt[n][k]), __builtin_bit_cast(bf16x8, At[m][k]), acc[ai][bj][m][n], 0, 0, 0); __builtin_amdgcn_s_setprio(0); } while (0)
#define PG_WAIT_V(n) asm volatile("s_waitcnt vmcnt(" #n ")" ::: "memory")
#define PG_WAIT_L(n) asm volatile("s_waitcnt lgkmcnt(" #n ")" ::: "memory")
#define PG_BAR __builtin_amdgcn_s_barrier()
#define PG_SCHED __builtin_amdgcn_sched_barrier(0)
    typename Sched::Unit cur, nxt; int ui = 0;
    if (!S.next(0, cur)) return;
    f32x4 acc[2][2][4][2];
#pragma unroll
    for (int a = 0; a < 2; ++a)
#pragma unroll
        for (int b = 0; b < 2; ++b)
#pragma unroll
            for (int m = 0; m < 4; ++m)
#pragma unroll
                for (int n = 0; n < 2; ++n) acc[a][b][m][n] = (f32x4){0.f, 0.f, 0.f, 0.f};
    s16x8 At[4][2], B0[2][2], B1[2][2];
    const char* cA; const char* cB; unsigned vA[2][2];
    S.addr(cur, RA, CA, cA, vA, cB);
    bool skip1 = Sched::half1_empty(cur);
    PG_STAGE(PG_SB(0, 0), cB, voffB); PG_STAGE(PG_SA(0, 0), cA, vA[0]); PG_STAGE(PG_SB(0, 1), cB + hstepB, voffB); PG_STAGE(PG_SA(0, 1), cA, vA[1]);
    if (wr == 1) PG_BAR;
    PG_WAIT_V(4); PG_BAR;
    PG_STAGE(PG_SB(1, 0), cB + kstep, voffB); PG_STAGE(PG_SA(1, 0), cA + kstep, vA[0]); PG_STAGE(PG_SB(1, 1), cB + hstepB + kstep, voffB);
    PG_WAIT_V(6); PG_BAR;
    for (;;) {
        const bool has_next = S.next(ui + 1, nxt);
        const char* nA = cA; const char* nB = cB; unsigned vN[2][2] = {{vA[0][0], vA[0][1]}, {vA[1][0], vA[1][1]}};
        if (has_next) S.addr(nxt, RA, CA, nA, vN, nB);
        for (int t = 0; t < nt; t += 2) {
            const bool last = (t == nt - 2);
            const char* a1 = cA + (size_t)(t + 1) * kstep;
            const char* a2 = last ? nA : cA + (size_t)(t + 2) * kstep; const char* b2 = last ? nB : cB + (size_t)(t + 2) * kstep;
            const char* a3 = a2 + kstep; const char* b3 = b2 + kstep;
            unsigned w0[2], w1[2];
            w0[0] = last ? vN[0][0] : vA[0][0]; w0[1] = last ? vN[0][1] : vA[0][1]; w1[0] = last ? vN[1][0] : vA[1][0]; w1[1] = last ? vN[1][1] : vA[1][1];
            PG_LDB(B0, 0, 0); PG_SCHED; PG_LDA(At, 0, 0); PG_STAGE(PG_SA(1, 1), a1, vA[1]);
            PG_WAIT_L(8); PG_BAR; PG_WAIT_L(0); PG_MMA(0, 0, At, B0); PG_BAR; PG_SCHED;
            PG_LDB(B1, 0, 1); PG_STAGE(PG_SB(0, 0), b2, voffB);
            PG_BAR; PG_WAIT_L(0); PG_MMA(0, 1, At, B1); PG_BAR;
            PG_LDA(At, 0, 1); PG_STAGE(PG_SA(0, 0), a2, w0);
            PG_BAR; PG_WAIT_L(0); PG_MMA(1, 0, At, B0); PG_BAR; PG_SCHED;
            PG_STAGE(PG_SB(0, 1), b2 + hstepB, voffB);
            PG_WAIT_V(6); PG_BAR; PG_MMA(1, 1, At, B1); PG_BAR;
            PG_LDB(B0, 1, 0); PG_SCHED; PG_LDA(At, 1, 0); PG_STAGE(PG_SA(0, 1), a2, w1);
            PG_WAIT_L(8); PG_BAR; PG_WAIT_L(0); PG_MMA(0, 0, At, B0); PG_BAR; PG_SCHED;
            PG_LDB(B1, 1, 1); PG_STAGE(PG_SB(1, 0), b3, voffB);
            PG_BAR; PG_WAIT_L(0); PG_MMA(0, 1, At, B1); PG_BAR;
            PG_LDA(At, 1, 1); PG_STAGE(PG_SA(1, 0), a3, w0);
            PG_BAR; PG_WAIT_L(0); PG_MMA(1, 0, At, B0); PG_BAR; PG_SCHED;
            PG_STAGE(PG_SB(1, 1), b3 + hstepB, voffB);
            PG_WAIT_V(6); PG_BAR; PG_MMA(1, 1, At, B1); PG_BAR;
        }
        E(acc, cur, wr, wc, fr, fq);
        if (!has_next) break;
#pragma unroll
        for (int a = 0; a < 2; ++a)
#pragma unroll
            for (int b = 0; b < 2; ++b)
#pragma unroll
                for (int m = 0; m < 4; ++m)
#pragma unroll
                    for (int n = 0; n < 2; ++n) acc[a][b][m][n] = (f32x4){0.f, 0.f, 0.f, 0.f};
        cur = nxt; cA = nA; cB = nB; ++ui; skip1 = Sched::half1_empty(cur);
        vA[0][0] = vN[0][0]; vA[0][1] = vN[0][1]; vA[1][0] = vN[1][0]; vA[1][1] = vN[1][1];
    }
    PG_WAIT_V(0);
    if (wr == 0) PG_BAR;
    PG_BAR;
#undef PG_SA
#undef PG_SB
#undef PG_STAGE
#undef PG_LDA
#undef PG_LDB
#undef PG_MMA
#undef PG_WAIT_V
#undef PG_WAIT_L
#undef PG_BAR
#undef PG_SCHED
}

struct DenseSched {
    struct Unit { int pm, pn; };
    static DI bool half1_empty(const Unit&) { return false; }
    const char* A; const char* Bt; int K, nM, nN, G, c;
    DI bool next(int i, Unit& u) const {
        const int nwg = nM * nN; const long L = (long)i * G + c; if (L >= nwg) return false;
        int wgid = (int)L; { const int q = nwg / 8, r = nwg % 8, xcd = wgid % 8, off = wgid / 8; wgid = (xcd < r ? xcd * (q + 1) : r * (q + 1) + (xcd - r) * q) + off; }
        const int nig = 8 * nN, gid = wgid / nig, fm = gid * 8, gsz = (nM - fm) < 8 ? (nM - fm) : 8;
        u.pm = fm + ((wgid % nig) % gsz); u.pn = (wgid % nig) / gsz; return true;
    }
    DI void addr(const Unit& u, const int (&R)[2], const int (&C)[2], const char*& aBase, unsigned (&vA)[2][2], const char*& bBase) const {
        aBase = A + (size_t)u.pm * 256 * K * 2; bBase = Bt + (size_t)u.pn * 256 * K * 2;
#pragma unroll
        for (int h = 0; h < 2; ++h)
#pragma unroll
            for (int i = 0; i < 2; ++i) vA[h][i] = (unsigned)((h * 128 + R[i]) * K + C[i]) * 2u;
    }
};
}

DI void transpose_block(const float* src, size_t lds_, bool valid, u16* d0, u16* d1, u16* d2, u16* d3) {
    f32x4 v[8];
#pragma unroll
    for (int j = 0; j < 8; ++j) v[j] = valid ? __builtin_nontemporal_load((const f32x4*)(src + (size_t)j * lds_)) : f32x4{0.f, 0.f, 0.f, 0.f};
    __builtin_nontemporal_store(u32x4{pack2(v[0].x, v[1].x), pack2(v[2].x, v[3].x), pack2(v[4].x, v[5].x), pack2(v[6].x, v[7].x)}, (u32x4*)d0);
    __builtin_nontemporal_store(u32x4{pack2(v[0].y, v[1].y), pack2(v[2].y, v[3].y), pack2(v[4].y, v[5].y), pack2(v[6].y, v[7].y)}, (u32x4*)d1);
    __builtin_nontemporal_store(u32x4{pack2(v[0].z, v[1].z), pack2(v[2].z, v[3].z), pack2(v[4].z, v[5].z), pack2(v[6].z, v[7].z)}, (u32x4*)d2);
    __builtin_nontemporal_store(u32x4{pack2(v[0].w, v[1].w), pack2(v[2].w, v[3].w), pack2(v[4].w, v[5].w), pack2(v[6].w, v[7].w)}, (u32x4*)d3);
}

DI void phase_convert(const Params& P) {
    const int tid = threadIdx.x, lane = tid & 63, wid = tid >> 6, kq = lane & 7, ng = lane >> 3;
    if (blockIdx.x == 0 && tid < 64) ((int*)(P.ws + WS_CNT))[tid] = 0;
    {
        u16* hi = (u16*)(P.ws + WS_WRT); u16* lo = hi + 80 * 1024;
        for (int idx = blockIdx.x * 512 + tid; idx < 80 * 1024; idx += gridDim.x * 512) {
            const int n = idx >> 10, k = idx & 1023;
            float w = 0.f;
            if (n < 8) w = P.w_rg[k * 8 + n]; else if (n < 72) w = P.w_re[k * 64 + (n - 8)];
            const u16 hb = f2bf(w);
            hi[idx] = hb; lo[idx] = f2bf(w - bf2f(hb));
        }
    }
    u16* wint = (u16*)(P.ws + WS_WINT); u16* woutt = (u16*)(P.ws + WS_WOUTT);
    const int gw = blockIdx.x * 8 + wid, nw = gridDim.x * 8;
    for (int T = gw; T < 1920 + 512; T += nw) {
        if (T < 1920) {
            const int kb = T / 120, nb = T - kb * 120;
            const int n4 = 32 * nb + 4 * ng;
            int src; bool valid = true;
            if (n4 < 1536) src = n4; else if (n4 < 3584) src = n4 + 16; else if (n4 < 3600) src = 1536 + (n4 - 3584); else if (n4 < 3608) src = n4; else { src = 0; valid = false; }
            u16* d = wint + (size_t)n4 * 1024 + 64 * kb + 8 * kq;
            transpose_block(P.w_in + (size_t)(64 * kb + 8 * kq) * WIN_LD + src, WIN_LD, valid, d, d + 1024, d + 2048, d + 3072);
        } else {
            const int t2 = T - 1920, kb = t2 >> 5, nb = t2 & 31;
            const int n4 = 32 * nb + 4 * ng;
            u16* d = woutt + (size_t)n4 * 1024 + 64 * kb + 8 * kq;
            transpose_block(P.w_out + (size_t)(64 * kb + 8 * kq) * DM + n4, DM, true, d, d + 1024, d + 2048, d + 3072);
        }
    }
    const float4* x4 = (const float4*)P.x; uint4* xb = (uint4*)(P.ws + WS_XB);
    for (int i = blockIdx.x * 512 + tid; i < NTOK * DM / 8; i += gridDim.x * 512) {
        const float4 a = x4[2 * i], b = x4[2 * i + 1];
        xb[i] = make_uint4(pack2(a.x, a.y), pack2(a.z, a.w), pack2(b.x, b.y), pack2(b.z, b.w));
    }
}

DI void convert_experts(const Params& P, int first_wave, int n_waves) {
    const int tid = threadIdx.x, lane = tid & 63, kq = lane & 7, ng = lane >> 3;
    u16* wgu = (u16*)(P.ws + WS_WGU); u16* wd = (u16*)(P.ws + WS_WD);
    for (int T = first_wave; T < 192 * 256; T += n_waves) {
        const int mat = T >> 8, t2 = T & 255;
        const int e = mat / 3, which = mat - e * 3;
        if (which < 2) {
            const int kb = t2 >> 4, nb = t2 & 15;
            const int n4 = 32 * nb + 4 * ng;
            const float* src = (which ? P.w_up : P.w_gate) + (size_t)e * (1024 * 512) + (size_t)(64 * kb + 8 * kq) * 512 + n4;
            u16* d = wgu + ((size_t)(e * 4 + (n4 >> 7)) * 256 + which * 128 + (n4 & 127)) * 1024 + 64 * kb + 8 * kq;
            transpose_block(src, 512, true, d, d + 1024, d + 2048, d + 3072);
        } else {
            const int kb = t2 >> 5, nb = t2 & 31;
            const int n4 = 32 * nb + 4 * ng;
            const float* src = P.w_down + (size_t)e * (512 * 1024) + (size_t)(64 * kb + 8 * kq) * 1024 + n4;
            u16* d = wd + ((size_t)e * 1024 + n4) * 512 + 64 * kb + 8 * kq;
            transpose_block(src, 1024, true, d, d + 512, d + 1024, d + 1536);
        }
    }
}

struct EpiInproj {
    u16* proj; float* small;
    DI void operator()(const pg::f32x4 (&acc)[2][2][4][2], const pg::DenseSched::Unit& u, int wr, int wc, int fr, int fq) const {
        const int row0 = u.pm * 256 + wr * 64 + fr;
        if (u.pn < 14) {
            const int col0 = u.pn * 256 + wc * 32 + 8 * fq;
#pragma unroll
            for (int ai = 0; ai < 2; ++ai)
#pragma unroll
                for (int m = 0; m < 4; ++m) {
                    u16* rowp = proj + (size_t)(row0 + ai * 128 + m * 16) * PLD + col0;
#pragma unroll
                    for (int bj = 0; bj < 2; ++bj) {
                        const pg::f32x4 v0 = acc[ai][bj][m][0], v1 = acc[ai][bj][m][1];
                        *(uint4*)(rowp + bj * 128) = make_uint4(pack2(v0[0], v0[1]), pack2(v0[2], v0[3]), pack2(v1[0], v1[1]), pack2(v1[2], v1[3]));
                    }
                }
        } else if (wc == 0 && fq < 3) {
#pragma unroll
            for (int ai = 0; ai < 2; ++ai)
#pragma unroll
                for (int m = 0; m < 4; ++m) {
                    float* rowp = small + (size_t)(row0 + ai * 128 + m * 16) * 24 + 8 * fq;
                    const pg::f32x4 v0 = acc[ai][0][m][0], v1 = acc[ai][0][m][1];
                    *(float4*)rowp = make_float4(v0[0], v0[1], v0[2], v0[3]); *(float4*)(rowp + 4) = make_float4(v1[0], v1[1], v1[2], v1[3]);
                }
        }
    }
};
DI void phase_inproj(const Params& P, char* lds) {
    pg::DenseSched S{(const char*)(P.ws + WS_XB), (const char*)(P.ws + WS_WINT), DM, 64, 15, (int)gridDim.x, (int)blockIdx.x};
    EpiInproj E{(u16*)(P.ws + WS_PROJ), (float*)(P.ws + WS_SMALL)};
    pg::gemm_phase(( LAS unsigned char*)lds, S, E, DM);
}

constexpr int PG_RAWQ = 0, PG_RAWK = 33792, PG_AMAT = 0, PG_T = 17408, PG_KN = 67584, PG_QN = 84992, PG_RT = 102400, PG_MISC = 139264;

constexpr int PGL_QE = 26624, PGL_KE = 35840, PGL_TB = 45056, PGL_W = 140288;
struct GlaIn { f32x4 l[4]; u32x4 q[2], k[2]; };
DI void gla_shadow(const Params& P, char* lds, int U, int wq, int lane, const GlaIn& gi);
DI void gla_attn_tiles(const Params& P, char* lds, int U, int wid, int lane);
struct PrepPre { u32x4 xin[11]; float bbv, abv; f32x4 gwv; float gb; };
DI void prep_prefetch(const Params& P, int U, int tid, PrepPre& pre) {
    const int c = U & 31, hd = (U >> 5) & 3, b = U >> 7;
    const int t0 = b * SEQ + c * 64;
    const u16* proj = (const u16*)(P.ws + WS_PROJ);
    const float* small = (const float*)(P.ws + WS_SMALL);
    if (tid < 384) {
        const int cg = tid % 48, pb = tid / 48;
        const int col = C_QB + (cg >> 4) * 512 + hd * 128 + (cg & 15) * 8;
#pragma unroll
        for (int j = 0; j < 11; ++j) {
            const int pos = pb * 8 - 3 + j;
            if (pos >= 0 || c > 0) pre.xin[j] = *(const u32x4*)(proj + (size_t)(t0 + pos) * PLD + col);
            else pre.xin[j] = u32x4{0u, 0u, 0u, 0u};
        }
    }
    if (tid < 64) { pre.bbv = small[(size_t)(t0 + tid) * 24 + 16 + hd]; pre.abv = small[(size_t)(t0 + tid) * 24 + 20 + hd]; }
    if (tid >= 256) {
        const int lt = tid - 256;
        pre.gwv = *(const f32x4*)(P.w_gk_up + (lt >> 4) * 256 + hd * 64 + (lt & 15) * 4);
        if (lt < 64) pre.gb = P.b_gk[hd * 64 + lt];
    }
}
DI void gdn_prep_unit(const Params& P, char* lds, int U, PrepPre& pre, int Unext) {
    int tidv = threadIdx.x;
    asm volatile("" : "+v"(tidv));
    const int tid = tidv, lane = tid & 63, wid = __builtin_amdgcn_readfirstlane(tid >> 6), r = lane & 31, h5 = lane >> 5;
    const int c = U & 31, hd = (U >> 5) & 3, b = U >> 7;
    const int t0 = b * SEQ + c * 64;
    const u16* proj = (const u16*)(P.ws + WS_PROJ);
    const float* small = (const float*)(P.ws + WS_SMALL);
    unsigned char* ub = P.ws + WS_GDN + (size_t)U * GDN_UNIT;
    u16* g_negw = (u16*)ub; u16* g_qd = (u16*)(ub + 16384); u16* g_kdt = (u16*)(ub + 32768); u16* g_attn = (u16*)(ub + 49152); u16* g_uf = (u16*)(ub + 57344);
    float* rawq = (float*)(lds + PG_RAWQ); float* rawk = (float*)(lds + PG_RAWK);
    float* amat = (float*)(lds + PG_AMAT);
    float* sgam = (float*)(lds + PG_MISC); float* sbeta = sgam + 64; float* srq = sgam + 128; float* srk = sgam + 192;

    GlaIn gin;
    if (wid >= 1 && wid <= 4) {
        const int tg = t0 + lane, dg = 16 * (wid - 1);
#pragma unroll
        for (int q = 0; q < 4; ++q) gin.l[q] = *(const f32x4*)(small + (size_t)tg * 24 + 4 * q);
        gin.q[0] = *(const u32x4*)(proj + (size_t)tg * PLD + C_QA + hd * 64 + dg); gin.q[1] = *(const u32x4*)(proj + (size_t)tg * PLD + C_QA + hd * 64 + dg + 8);
        gin.k[0] = *(const u32x4*)(proj + (size_t)tg * PLD + C_KA + hd * 64 + dg); gin.k[1] = *(const u32x4*)(proj + (size_t)tg * PLD + C_KA + hd * 64 + dg + 8);
    }
    if (wid >= 4) {
        const int lt = tid - 256;
        float* gw = (float*)(lds + PGL_W);
        *(f32x4*)(gw + lt * 4) = pre.gwv;
        if (lt < 64) gw[1024 + lt] = pre.gb;
    }
    if (wid == 0) {
        const float bbv = pre.bbv, abv = pre.abv;
        const float z = abv + P.dt_bias[hd];
        const float sp = z > 20.f ? z : (z < -15.f ? __expf(z) : __logf(1.f + __expf(z)));
        float g = -__expf(P.a_log[hd]) * sp;
        g = wave_scan_incl(g);
        sgam[lane] = g; sbeta[lane] = 1.f / (1.f + __expf(-bbv));
    }
    __syncthreads();
    if (tid < 384) {
        const int cg = tid % 48, pb = tid / 48;
        const int which = cg >> 4, d0 = (cg & 15) * 8;
        const int col = C_QB + which * 512 + hd * 128 + d0;
        const int cch = which * 512 + hd * 128 + d0;
        float w[4][8];
#pragma unroll
        for (int i = 0; i < 4; ++i) {
            const float4 a = *(const float4*)(P.conv_w + i * 1536 + cch), b2 = *(const float4*)(P.conv_w + i * 1536 + cch + 4);
            w[i][0] = a.x; w[i][1] = a.y; w[i][2] = a.z; w[i][3] = a.w; w[i][4] = b2.x; w[i][5] = b2.y; w[i][6] = b2.z; w[i][7] = b2.w;
        }
        float sv[8][8];
#pragma unroll
        for (int p = 0; p < 8; ++p) {
#pragma unroll
            for (int ch2 = 0; ch2 < 4; ++ch2) {
                float y0 = 0.f, y1 = 0.f;
#pragma unroll
                for (int i = 0; i < 4; ++i) {
                    const u32x4 xr = pre.xin[p + i];
                    const unsigned xw = ch2 == 0 ? xr.x : (ch2 == 1 ? xr.y : (ch2 == 2 ? xr.z : xr.w));
                    y0 += w[i][2 * ch2] * bflo(xw); y1 += w[i][2 * ch2 + 1] * bfhi(xw);
                }
                sv[p][2 * ch2] = silu_f(y0); sv[p][2 * ch2 + 1] = silu_f(y1);
            }
        }
        if (which < 2) {
            float* dst = (which ? rawk : rawq) + (pb * 8) * 132 + d0;
#pragma unroll
            for (int p = 0; p < 8; ++p) {
                *(float4*)(dst + p * 132) = make_float4(sv[p][0], sv[p][1], sv[p][2], sv[p][3]);
                *(float4*)(dst + p * 132 + 4) = make_float4(sv[p][4], sv[p][5], sv[p][6], sv[p][7]);
            }
        } else {
            float bt[8];
#pragma unroll
            for (int p = 0; p < 8; ++p) bt[p] = sbeta[pb * 8 + p];
#pragma unroll
            for (int ch = 0; ch < 8; ++ch)
                *(uint4*)(lds + PG_RT + (d0 + ch) * 144 + pb * 16) =
                    make_uint4(pack2(bt[0] * sv[0][ch], bt[1] * sv[1][ch]), pack2(bt[2] * sv[2][ch], bt[3] * sv[3][ch]), pack2(bt[4] * sv[4][ch], bt[5] * sv[5][ch]), pack2(bt[6] * sv[6][ch], bt[7] * sv[7][ch]));
        }
    }
    __syncthreads();
    if (tid < 128) {
        const int pos = tid & 63, which = tid >> 6;
        const float* src = (which ? rawk : rawq) + pos * 132;
        float ss = 0.f;
#pragma unroll 8
        for (int d = 0; d < 128; d += 4) { const float4 v = *(const float4*)(src + d); ss += v.x * v.x + v.y * v.y + v.z * v.z + v.w * v.w; }
        const float rn = rsqrtf(ss + 1e-6f);
        if (which) srk[pos] = rn; else srq[pos] = rn * 0.08838834764831845f;
    }
    __syncthreads();
    {
        const int d = tid & 127, pq = tid >> 7;
        const float glast = sgam[63];
        unsigned kd[8], rt[8];
#pragma unroll
        for (int j2 = 0; j2 < 8; ++j2) {
            float kdv[2], rtv[2];
#pragma unroll
            for (int e = 0; e < 2; ++e) {
                const int pos = pq * 16 + j2 * 2 + e;
                const float gm = sgam[pos];
                const float eg = __expf(gm), ek = __expf(glast - gm);
                const float kn = rawk[pos * 132 + d] * srk[pos];
                const float qn = rawq[pos * 132 + d] * srq[pos];
                *(u16*)(lds + PG_KN + pos * 272 + d * 2) = f2bf(kn);
                *(u16*)(lds + PG_QN + pos * 272 + d * 2) = f2bf(qn);
                g_qd[pos * 128 + d] = f2bf(qn * eg);
                kdv[e] = kn * ek; rtv[e] = sbeta[pos] * kn * eg;
            }
            kd[j2] = pack2(kdv[0], kdv[1]); rt[j2] = pack2(rtv[0], rtv[1]);
        }
        uint4* kp = (uint4*)(g_kdt + d * 64 + pq * 16);
        kp[0] = make_uint4(kd[0], kd[1], kd[2], kd[3]); kp[1] = make_uint4(kd[4], kd[5], kd[6], kd[7]);
        uint4* rp = (uint4*)(lds + PG_RT + (128 + d) * 144 + pq * 32);
        rp[0] = make_uint4(rt[0], rt[1], rt[2], rt[3]); rp[1] = make_uint4(rt[4], rt[5], rt[6], rt[7]);
        if (tid == 0) ((float*)(P.ws + WS_DL))[U] = __expf(glast);
    }
    __syncthreads();
    {
        const int which = wid >> 2, ti = (wid >> 1) & 1, tj = wid & 1;
        f32x16 acc;
#pragma unroll
        for (int i = 0; i < 16; ++i) acc[i] = 0.f;
        if (!(ti == 0 && tj == 1)) {
            const char* xa = lds + (which ? PG_QN : PG_KN) + (32 * ti + r) * 272 + h5 * 16;
            const char* xb = lds + PG_KN + (32 * tj + r) * 272 + h5 * 16;
#pragma unroll
            for (int ks = 0; ks < 8; ++ks) acc = mfma32(ld_frag(xa + ks * 32), ld_frag(xb + ks * 32), acc);
        }
        const int j = 32 * tj + r;
        const float gj = sgam[j];
#pragma unroll
        for (int i = 0; i < 16; ++i) {
            const int ii = 32 * ti + crow(i, h5);
            const float dec = __expf(fminf(sgam[ii] - gj, 0.f));
            if (which == 0) amat[ii * 68 + j] = (j < ii) ? sbeta[ii] * acc[i] * dec : 0.f;
            else g_attn[ii * 64 + j] = f2bf((j <= ii) ? acc[i] * dec : 0.f);
        }
    }
    __syncthreads();
    if (Unext >= 0 && wid != 0) prep_prefetch(P, Unext, tid, pre);
    if (wid == 0) {
        const int hb = lane >> 5, cb = lane & 31;
        const float* ab = amat + (32 * hb) * 68 + 32 * hb;
        float* tbs = (float*)(lds + PGL_TB) + hb * (32 * 33);
        float t[32];
        float4 an[8], ac[8];
        float dn = 0.f, dc;
#define INV_LOAD(i, dst) do { _Pragma("unroll") for (int q = 0; q < 8; ++q) if (q < ((i) + 3) / 4) dst[q] = *(const float4*)(ab + abo + (i) * 68 + 4 * q); } while (0)
        dc = ab[cb];
#pragma unroll
        for (int q = 0; q < 8; ++q) { ac[q] = make_float4(0.f, 0.f, 0.f, 0.f); an[q] = make_float4(0.f, 0.f, 0.f, 0.f); }
        int abo = 0;
#pragma unroll
        for (int i = 0; i < 32; ++i) {
            { const float tp = (i > 0) ? t[i > 0 ? i - 1 : 0] : dc; asm volatile("" : "+v"(abo) : "v"(tp)); }
            if (i + 1 < 32) { dn = (ab + abo)[(i + 1) * 68 + cb]; INV_LOAD(i + 1, an); }
            __builtin_amdgcn_sched_barrier(0);
            float s0 = -dc, s1 = 0.f;
#pragma unroll
            for (int q = 0; q < 8; ++q) { const int j = 4 * q;
                if (j + 0 < i) s0 -= ac[q].x * t[j + 0]; if (j + 1 < i) s1 -= ac[q].y * t[j + 1];
                if (j + 2 < i) s0 -= ac[q].z * t[j + 2]; if (j + 3 < i) s1 -= ac[q].w * t[j + 3]; }
            t[i] = s0 + s1; dc = dn;
            __builtin_amdgcn_sched_barrier(0);
#pragma unroll
            for (int q = 0; q < 8; ++q) ac[q] = an[q];
        }
#undef INV_LOAD
#pragma unroll
        for (int i = 0; i < 32; ++i) {
            *(u16*)(lds + PG_T + (32 * hb + i) * 144 + (32 * hb + cb) * 2) = f2bf(t[i]);
            tbs[i * 33 + cb] = t[i];
            if (hb) *(u16*)(lds + PG_T + i * 144 + (32 + cb) * 2) = (u16)0;
        }
        *(u16*)(lds + PG_T + lane * 144 + lane * 2) = (u16)0x3F80;
        tbs[cb * 33 + cb] = 1.f;
        const float* t11 = (const float*)(lds + PGL_TB); const float* t22 = t11 + 32 * 33;
        f32x16 ax, at;
#pragma unroll
        for (int i = 0; i < 16; ++i) { ax[i] = 0.f; at[i] = 0.f; }
        static_for<16>([&](auto skc) {
            constexpr int sk = decltype(skc)::value;
            ax = __builtin_amdgcn_mfma_f32_32x32x2f32(amat[(32 + cb) * 68 + 2 * sk + hb], t11[(2 * sk + hb) * 33 + cb], ax, 0, 0, 0);
        });
        static_for<16>([&](auto skc) {
            constexpr int sk = decltype(skc)::value;
            constexpr int r0 = (sk & 3) + 8 * (sk >> 2);
            at = __builtin_amdgcn_mfma_f32_32x32x2f32(t22[cb * 33 + r0 + 4 * hb], ax[sk], at, 0, 0, 0);
        });
#pragma unroll
        for (int i = 0; i < 16; ++i) *(u16*)(lds + PG_T + (32 + crow(i, hb)) * 144 + cb * 2) = f2bf(-at[i]);
        if (Unext >= 0) prep_prefetch(P, Unext, tid, pre);
    } else if (wid <= 4) {
        gla_shadow(P, lds, U, wid - 1, lane, gin);
    }
    __syncthreads();
    if (wid < 4) gla_attn_tiles(P, lds, U, wid, lane);
    {
        f32x16 acc[2];
#pragma unroll
        for (int m = 0; m < 2; ++m)
#pragma unroll
            for (int i = 0; i < 16; ++i) acc[m][i] = 0.f;
        const char* tb = lds + PG_T + r * 144 + h5 * 16;
        const char* rb = lds + PG_RT + (32 * wid + r) * 144 + h5 * 16;
#pragma unroll
        for (int ks = 0; ks < 4; ++ks) {
            const bf16x8 bfr = ld_frag(rb + ks * 32);
#pragma unroll
            for (int m = 0; m < 2; ++m) acc[m] = mfma32(ld_frag(tb + m * 32 * 144 + ks * 32), bfr, acc[m]);
        }
        if (wid < 4) {
#pragma unroll
            for (int m = 0; m < 2; ++m) {
                uint4* up = (uint4*)(g_uf + ((size_t)(wid * 2 + m) * 64 + lane) * 16);
                up[0] = make_uint4(pack2(acc[m][0], acc[m][1]), pack2(acc[m][2], acc[m][3]), pack2(acc[m][4], acc[m][5]), pack2(acc[m][6], acc[m][7]));
                up[1] = make_uint4(pack2(acc[m][8], acc[m][9]), pack2(acc[m][10], acc[m][11]), pack2(acc[m][12], acc[m][13]), pack2(acc[m][14], acc[m][15]));
            }
        } else {
#pragma unroll
            for (int m = 0; m < 2; ++m)
#pragma unroll
                for (int i = 0; i < 16; ++i) g_negw[(32 * m + crow(i, h5)) * 128 + 32 * (wid - 4) + r] = f2bf(-acc[m][i]);
        }
    }
    __syncthreads();
}

DI void gla_shadow(const Params& P, char* lds, int U, int wq, int lane, const GlaIn& gi) {
    unsigned char* ub = P.ws + WS_GLA + (size_t)U * GLA_UNIT;
    u16* g_qe = (u16*)ub; u16* g_kdt = (u16*)(ub + 16384); float* g_dec = (float*)(ub + 24576);
    const float* gw = (const float*)(lds + PGL_W);
    const int d0 = 16 * wq;
    const float lr[16] = {gi.l[0].x, gi.l[0].y, gi.l[0].z, gi.l[0].w, gi.l[1].x, gi.l[1].y, gi.l[1].z, gi.l[1].w, gi.l[2].x, gi.l[2].y, gi.l[2].z, gi.l[2].w, gi.l[3].x, gi.l[3].y, gi.l[3].z, gi.l[3].w};
    const unsigned qw[8] = {gi.q[0].x, gi.q[0].y, gi.q[0].z, gi.q[0].w, gi.q[1].x, gi.q[1].y, gi.q[1].z, gi.q[1].w}, kw[8] = {gi.k[0].x, gi.k[0].y, gi.k[0].z, gi.k[0].w, gi.k[1].x, gi.k[1].y, gi.k[1].z, gi.k[1].w};
    unsigned qe[8], ke[8];
#pragma unroll
    for (int g4 = 0; g4 < 4; ++g4) {
        const float4 bz = *(const float4*)(gw + 1024 + d0 + 4 * g4);
        float z[4] = {bz.x, bz.y, bz.z, bz.w};
#pragma unroll
        for (int r = 0; r < 16; ++r) {
            const float4 wv = *(const float4*)(gw + r * 64 + d0 + 4 * g4);
            z[0] += lr[r] * wv.x; z[1] += lr[r] * wv.y; z[2] += lr[r] * wv.z; z[3] += lr[r] * wv.w;
        }
        float bb[4], blast[4];
#pragma unroll
        for (int e = 0; e < 4; ++e) bb[e] = (fminf(z[e], 0.f) - __logf(1.f + __expf(-fabsf(z[e])))) * 0.0625f;
#pragma unroll
        for (int e = 0; e < 4; ++e) bb[e] = wave_scan_incl(bb[e]);
#pragma unroll
        for (int e = 0; e < 4; ++e) blast[e] = __builtin_bit_cast(float, __builtin_amdgcn_readlane(__builtin_bit_cast(int, bb[e]), 63));
        float qev[4], kev[4];
#pragma unroll
        for (int e = 0; e < 4; ++e) {
            const int j = 4 * g4 + e, d = d0 + j;
            const float q = ((j & 1) ? bfhi(qw[j >> 1]) : bflo(qw[j >> 1])) * 0.125f, k = (j & 1) ? bfhi(kw[j >> 1]) : bflo(kw[j >> 1]);
            qev[e] = q * __expf(bb[e]); kev[e] = k * __expf(-bb[e]);
            g_kdt[d * 64 + lane] = f2bf(k * __expf(blast[e] - bb[e]));
            if (lane == 0) g_dec[d] = __expf(blast[e]);
        }
        qe[2 * g4] = pack2(qev[0], qev[1]); qe[2 * g4 + 1] = pack2(qev[2], qev[3]);
        ke[2 * g4] = pack2(kev[0], kev[1]); ke[2 * g4 + 1] = pack2(kev[2], kev[3]);
    }
    const uint4 qa = make_uint4(qe[0], qe[1], qe[2], qe[3]), qb = make_uint4(qe[4], qe[5], qe[6], qe[7]);
    *(uint4*)(lds + PGL_QE + lane * 144 + d0 * 2) = qa; *(uint4*)(lds + PGL_QE + lane * 144 + d0 * 2 + 16) = qb;
    *(uint4*)(lds + PGL_KE + lane * 144 + d0 * 2) = make_uint4(ke[0], ke[1], ke[2], ke[3]); *(uint4*)(lds + PGL_KE + lane * 144 + d0 * 2 + 16) = make_uint4(ke[4], ke[5], ke[6], ke[7]);
    *(uint4*)(g_qe + lane * 64 + d0) = qa; *(uint4*)(g_qe + lane * 64 + d0 + 8) = qb;
}
DI void gla_attn_tiles(const Params& P, char* lds, int U, int wid, int lane) {
    const int r = lane & 31, h5 = lane >> 5;
    u16* g_attn = (u16*)(P.ws + WS_GLA + (size_t)U * GLA_UNIT + 8192);
    const int ti = wid >> 1, tj = wid & 1;
    f32x16 acc;
#pragma unroll
    for (int i = 0; i < 16; ++i) acc[i] = 0.f;
    if (!(ti == 0 && tj == 1)) {
        const char* xa = lds + PGL_QE + (32 * ti + r) * 144 + h5 * 16;
        const char* xb = lds + PGL_KE + (32 * tj + r) * 144 + h5 * 16;
#pragma unroll
        for (int ks = 0; ks < 4; ++ks) acc = mfma32(ld_frag(xa + ks * 32), ld_frag(xb + ks * 32), acc);
    }
    const int j = 32 * tj + r;
#pragma unroll
    for (int i = 0; i < 16; ++i) {
        const int ii = 32 * ti + crow(i, h5);
        g_attn[ii * 64 + j] = f2bf((j <= ii) ? acc[i] : 0.f);
    }
}

DI void phase_prep(const Params& P, char* lds) {
    PrepPre pre;
    if ((int)blockIdx.x < 1024) prep_prefetch(P, blockIdx.x, threadIdx.x, pre);
    for (int u = blockIdx.x; u < 1024; u += gridDim.x) {
        const int un = u + (int)gridDim.x;
        gdn_prep_unit(P, lds, u, pre, un < 1024 ? un : -1);
    }
}

template <bool GDN> struct ScanCfg;
template <> struct ScanCfg<true>  { static constexpr int DK = 128, LDA = 264, NEGW = 0, QD = 16896, KDT = 33792, ATT = 51200, DEC = 0, STAGE = 59904; };
template <> struct ScanCfg<false> { static constexpr int DK = 64,  LDA = 136, NEGW = 0, QD = 0,     KDT = 8704,  ATT = 17408, DEC = 26112, STAGE = 26368; };
constexpr int SC_OST = 2 * 59904, SC_OSTB = 16896;

template <bool GDN>
DI void scan_stream(const Params& P, char* lds, int bh) {
    using C = ScanCfg<GDN>;
    constexpr int DK = C::DK, KT = DK / 32, KS = DK / 16;
    const int tid = threadIdx.x, lane = tid & 63, wid = tid >> 6, r = lane & 31, h5 = lane >> 5;
    const int hd = bh & 3, b = bh >> 2;
    const u16* proj = (const u16*)(P.ws + WS_PROJ);
    u16* mixed = (u16*)(P.ws + WS_MIXED);
    const int U0 = bh * 32;

    if (wid >= 4) {
        const int lt = tid - 256;
        const int epos = lt >> 2, eq = lt & 3;
        float* sgain = (float*)(lds + 153600);
        if (lt < 128) sgain[lt] = (GDN ? P.gdn_g : P.gla_g)[lt];
        const int gcol = (GDN ? C_ZB : C_RA) + hd * 128 + eq * 32;
        const int ocol = (GDN ? 512 : 0) + hd * 128 + eq * 32;
        constexpr int NV = GDN ? 14 : 6;
        uint4 sv[NV]; float sdv = 0.f; uint4 gq[4];
        auto load_chunk = [&](int cidx) {
            if (GDN) {
                const unsigned char* ub = P.ws + WS_GDN + (size_t)(U0 + cidx) * GDN_UNIT;
#pragma unroll
                for (int q = 0; q < 4; ++q) sv[q] = ldnt_u4(ub + (size_t)(lt + 256 * q) * 16);
#pragma unroll
                for (int q = 0; q < 4; ++q) sv[4 + q] = ldnt_u4(ub + 16384 + (size_t)(lt + 256 * q) * 16);
#pragma unroll
                for (int q = 0; q < 4; ++q) sv[8 + q] = ldnt_u4(ub + 32768 + (size_t)(lt + 256 * q) * 16);
#pragma unroll
                for (int q = 0; q < 2; ++q) sv[12 + q] = ldnt_u4(ub + 49152 + (size_t)(lt + 256 * q) * 16);
            } else {
                const unsigned char* ub = P.ws + WS_GLA + (size_t)(U0 + cidx) * GLA_UNIT;
#pragma unroll
                for (int q = 0; q < 6; ++q) sv[q] = ldnt_u4(ub + (size_t)(lt + 256 * q) * 16);
                if (lt < 64) sdv = *(const float*)(ub + 24576 + lt * 4);
            }
        };
        int o264 = (lt >> 4) * 264 + (lt & 15) * 16, o136 = (lt >> 3) * 136 + (lt & 7) * 16;
        auto write_chunk = [&](char* st) {
            if (GDN) {
#pragma unroll
                for (int q = 0; q < 4; ++q) { char* d = st + C::NEGW + o264 + q * (16 * 264); *(uint2*)d = make_uint2(sv[q].x, sv[q].y); *(uint2*)(d + 8) = make_uint2(sv[q].z, sv[q].w); }
#pragma unroll
                for (int q = 0; q < 4; ++q) { char* d = st + C::QD + o264 + q * (16 * 264); *(uint2*)d = make_uint2(sv[4 + q].x, sv[4 + q].y); *(uint2*)(d + 8) = make_uint2(sv[4 + q].z, sv[4 + q].w); }
#pragma unroll
                for (int q = 0; q < 4; ++q) { char* d = st + C::KDT + o136 + q * (32 * 136); *(uint2*)d = make_uint2(sv[8 + q].x, sv[8 + q].y); *(uint2*)(d + 8) = make_uint2(sv[8 + q].z, sv[8 + q].w); }
#pragma unroll
                for (int q = 0; q < 2; ++q) { char* d = st + C::ATT + o136 + q * (32 * 136); *(uint2*)d = make_uint2(sv[12 + q].x, sv[12 + q].y); *(uint2*)(d + 8) = make_uint2(sv[12 + q].z, sv[12 + q].w); }
            } else {
#pragma unroll
                for (int q = 0; q < 6; ++q) {
                    const int base = (q >> 1) == 0 ? C::QD : ((q >> 1) == 1 ? C::ATT : C::KDT);
                    char* d = st + base + o136 + (q & 1) * (32 * 136);
                    *(uint2*)d = make_uint2(sv[q].x, sv[q].y); *(uint2*)(d + 8) = make_uint2(sv[q].z, sv[q].w);
                }
                if (lt < 64) *(float*)(st + C::DEC + lt * 4) = sdv;
            }
        };
        auto load_gate = [&](int cidx) {
            const uint4* gp4 = (const uint4*)(proj + (size_t)(b * SEQ + cidx * 64 + epos) * PLD + gcol);
            gq[0] = gp4[0]; gq[1] = gp4[1]; gq[2] = gp4[2]; gq[3] = gp4[3];
        };
        auto epilogue = [&](int cidx) {
            const int t = b * SEQ + cidx * 64 + epos;
            const char* orow = lds + SC_OST + (cidx & 1) * SC_OSTB + epos * 264 + eq * 64;
            unsigned ov[16];
#pragma unroll
            for (int q = 0; q < 8; ++q) { const uint2 x2 = *(const uint2*)(orow + q * 8); ov[2 * q] = x2.x; ov[2 * q + 1] = x2.y; }
            float ss = 0.f;
#pragma unroll
            for (int q = 0; q < 16; ++q) { const float a = bflo(ov[q]), c2 = bfhi(ov[q]); ss += a * a + c2 * c2; }
            ss += __shfl_xor(ss, 1, 64); ss += __shfl_xor(ss, 2, 64);
            const float rstd = rsqrtf(ss * (1.f / 128.f) + 1e-6f);
            const unsigned gv[16] = {gq[0].x, gq[0].y, gq[0].z, gq[0].w, gq[1].x, gq[1].y, gq[1].z, gq[1].w, gq[2].x, gq[2].y, gq[2].z, gq[2].w, gq[3].x, gq[3].y, gq[3].z, gq[3].w};
            unsigned res[16];
#pragma unroll
            for (int q4 = 0; q4 < 8; ++q4) {
                const float4 gn = *(const float4*)(sgain + eq * 32 + q4 * 4);
                const int q = 2 * q4;
                res[q] = pack2(bflo(ov[q]) * rstd * gn.x * silu_f(bflo(gv[q])), bfhi(ov[q]) * rstd * gn.y * silu_f(bfhi(gv[q])));
                res[q + 1] = pack2(bflo(ov[q + 1]) * rstd * gn.z * silu_f(bflo(gv[q + 1])), bfhi(ov[q + 1]) * rstd * gn.w * silu_f(bfhi(gv[q + 1])));
            }
            uint4* op = (uint4*)(mixed + (size_t)t * DM + ocol);
            op[0] = make_uint4(res[0], res[1], res[2], res[3]); op[1] = make_uint4(res[4], res[5], res[6], res[7]);
            op[2] = make_uint4(res[8], res[9], res[10], res[11]); op[3] = make_uint4(res[12], res[13], res[14], res[15]);
        };
        load_chunk(0);
        write_chunk(lds);
        load_chunk(1);
        load_gate(0);
        __syncthreads();
        for (int c = 0; c < NCH; ++c) {
            asm volatile("" : "+v"(o264), "+v"(o136));
            if (c + 1 < NCH) write_chunk(lds + ((c + 1) & 1) * 59904);
            if (c + 2 < NCH) load_chunk(c + 2);
            if (c > 0) { epilogue(c - 1); load_gate(c); }
            __syncthreads();
        }
        epilogue(NCH - 1);
    } else {
        f32x16 S[KT];
        bf16x8 Sb[KS];
#pragma unroll
        for (int k = 0; k < KT; ++k)
#pragma unroll
            for (int i = 0; i < 16; ++i) S[k][i] = 0.f;
#pragma unroll
        for (int k = 0; k < KS; ++k) { u32x4 z = {0u, 0u, 0u, 0u}; Sb[k] = __builtin_bit_cast(bf16x8, z); }
        const float* dlp = (const float*)(P.ws + WS_DL) + U0;
        uint4 un[4];
        u16 vnx[32];
        auto fetch_uv = [&](int cidx) {
            if (GDN) {
                const uint4* up = (const uint4*)(P.ws + WS_GDN + (size_t)(U0 + cidx) * GDN_UNIT + 57344) + ((size_t)(wid * 2) * 64 + lane) * 2;
                un[0] = ldnt_u4(up); un[1] = ldnt_u4(up + 1); un[2] = ldnt_u4(up + 128); un[3] = ldnt_u4(up + 129);
            } else {
                const u16* vp = proj + (size_t)(b * SEQ + cidx * 64) * PLD + C_VA + hd * 128 + 32 * wid + r;
#pragma unroll
                for (int m = 0; m < 2; ++m)
#pragma unroll
                    for (int i = 0; i < 16; ++i) vnx[m * 16 + i] = vp[(size_t)(32 * m + crow(i, h5)) * PLD];
            }
        };
        fetch_uv(0);
        __syncthreads();
        constexpr int NOPS = GDN ? 56 : 24, N1 = GDN ? 32 : 8, N2 = N1 + 8;
        int rA = r * C::LDA + 8 * h5, r136 = r * 136 + 8 * h5;
#define SC_OFF(n) ((n) < N1 ? (GDN ? ((((n) & 1) ? C::QD : C::NEGW) + 32 * (((n) >> 1) & 1) * C::LDA + 32 * ((n) >> 2)) : (C::QD + 32 * ((n) & 1) * C::LDA + 32 * ((n) >> 1))) \
                  : ((n) < N2 ? (C::ATT + 32 * (((n) - N1) & 1) * 136 + 32 * (((n) - N1) >> 1)) : (C::KDT + 32 * (((n) - N2) >> 2) * 136 + 32 * (((n) - N2) & 3))))
#define SC_LDF(n) ld_frag2(st + SC_OFF(n) + ((n) < N1 ? rA : r136))
        for (int c = 0; c < NCH; ++c) {
            asm volatile("" : "+v"(rA), "+v"(r136));
            const char* st = lds + (c & 1) * 59904;
            bf16x8 fq[4];
#pragma unroll
            for (int n = 0; n < 4; ++n) fq[n] = SC_LDF(n);
            f32x16 vn[2];
            if (GDN) {
                const unsigned w0[8] = {un[0].x, un[0].y, un[0].z, un[0].w, un[1].x, un[1].y, un[1].z, un[1].w};
                const unsigned w1[8] = {un[2].x, un[2].y, un[2].z, un[2].w, un[3].x, un[3].y, un[3].z, un[3].w};
#pragma unroll
                for (int q = 0; q < 8; ++q) { vn[0][2 * q] = bflo(w0[q]); vn[0][2 * q + 1] = bfhi(w0[q]); vn[1][2 * q] = bflo(w1[q]); vn[1][2 * q + 1] = bfhi(w1[q]); }
            } else {
#pragma unroll
                for (int m = 0; m < 2; ++m)
#pragma unroll
                    for (int i = 0; i < 16; ++i) vn[m][i] = bf2f(vnx[m * 16 + i]);
            }
            const float dl = GDN ? dlp[c] : 0.f;
            f32x16 o[2];
#pragma unroll
            for (int m = 0; m < 2; ++m)
#pragma unroll
                for (int i = 0; i < 16; ++i) o[m][i] = 0.f;
            bf16x8 vb[4];
            if (!GDN) { vb[0] = pack8<0>(vn[0]); vb[1] = pack8<1>(vn[0]); vb[2] = pack8<0>(vn[1]); vb[3] = pack8<1>(vn[1]); }
            static_for<NOPS>([&](auto nc) {
                constexpr int n = decltype(nc)::value;
                const bf16x8 af = fq[n & 3];
                if constexpr (n + 4 < NOPS) fq[n & 3] = SC_LDF(n + 4);
                if constexpr (n < N1) {
                    if constexpr (GDN) {
                        constexpr int ks = n >> 2, m = (n >> 1) & 1;
                        if constexpr ((n & 1) == 0) vn[m] = mfma32(af, Sb[ks], vn[m]); else o[m] = mfma32(af, Sb[ks], o[m]);
                    } else {
                        constexpr int ks = n >> 1, m = n & 1;
                        o[m] = mfma32(af, Sb[ks], o[m]);
                    }
                } else if constexpr (n < N2) {
                    constexpr int ks = (n - N1) >> 1, m = (n - N1) & 1;
                    o[m] = mfma32(af, vb[ks], o[m]);
                } else {
                    constexpr int kt = (n - N2) >> 2, ks = (n - N2) & 3;
                    S[kt] = mfma32(af, vb[ks], S[kt]);
                }
                __builtin_amdgcn_sched_group_barrier(0x008, 1, 0);
                __builtin_amdgcn_sched_group_barrier(0x100, 2, 0);
                if constexpr (n == N1 - 1) {
                    if constexpr (GDN) { vb[0] = pack8<0>(vn[0]); vb[1] = pack8<1>(vn[0]); vb[2] = pack8<0>(vn[1]); vb[3] = pack8<1>(vn[1]); }
                    if (c + 1 < NCH) fetch_uv(c + 1);
#pragma unroll
                    for (int k = 0; k < KT; ++k) {
                        if constexpr (GDN) {
#pragma unroll
                            for (int i = 0; i < 16; ++i) S[k][i] *= dl;
                        } else {
#pragma unroll
                            for (int q = 0; q < 4; ++q) {
                                const float4 dc = *(const float4*)(st + C::DEC + (32 * k + 8 * q + 4 * h5) * 4);
                                S[k][4 * q] *= dc.x; S[k][4 * q + 1] *= dc.y; S[k][4 * q + 2] *= dc.z; S[k][4 * q + 3] *= dc.w;
                            }
                        }
                    }
                }
            });
#pragma unroll
            for (int k = 0; k < KT; ++k) { Sb[2 * k] = pack8<0>(S[k]); Sb[2 * k + 1] = pack8<1>(S[k]); }
            char* ost = lds + SC_OST + (c & 1) * SC_OSTB;
#pragma unroll
            for (int m = 0; m < 2; ++m)
#pragma unroll
                for (int i = 0; i < 16; ++i) *(u16*)(ost + (32 * m + crow(i, h5)) * 264 + (32 * wid + r) * 2) = f2bf(o[m][i]);
            __syncthreads();
        }
#undef SC_OFF
#undef SC_LDF
    }
}

DI void phase_scan(const Params& P, char* lds) {
    const int wid = threadIdx.x >> 6;
    if (gridDim.x >= 128) {
        if (blockIdx.x < 64) { if (blockIdx.x < 32) scan_stream<true>(P, lds, blockIdx.x); else scan_stream<false>(P, lds, blockIdx.x - 32); }
        else convert_experts(P, (blockIdx.x - 64) * 8 + wid, (gridDim.x - 64) * 8);
    } else {
        for (int s = blockIdx.x; s < 64; s += gridDim.x) {
            if (s < 32) scan_stream<true>(P, lds, s); else scan_stream<false>(P, lds, s - 32);
            __syncthreads();
        }
        convert_experts(P, blockIdx.x * 8 + wid, gridDim.x * 8);
    }
}

struct EpiOutproj {
    u16* hbuf;
    DI void operator()(const pg::f32x4 (&acc)[2][2][4][2], const pg::DenseSched::Unit& u, int wr, int wc, int fr, int fq) const {
        const int row0 = u.pm * 256 + wr * 64 + fr, col0 = u.pn * 256 + wc * 32 + 8 * fq;
#pragma unroll
        for (int ai = 0; ai < 2; ++ai)
#pragma unroll
            for (int m = 0; m < 4; ++m) {
                u16* rowp = hbuf + (size_t)(row0 + ai * 128 + m * 16) * DM + col0;
#pragma unroll
                for (int bj = 0; bj < 2; ++bj) {
                    const pg::f32x4 v0 = acc[ai][bj][m][0], v1 = acc[ai][bj][m][1];
                    *(uint4*)(rowp + bj * 128) = make_uint4(pack2(v0[0], v0[1]), pack2(v0[2], v0[3]), pack2(v1[0], v1[1]), pack2(v1[2], v1[3]));
                }
            }
    }
};
DI void phase_outproj(const Params& P, char* lds) {
    pg::DenseSched S{(const char*)(P.ws + WS_MIXED), (const char*)(P.ws + WS_WOUTT), DM, 64, 4, (int)gridDim.x, (int)blockIdx.x};
    EpiOutproj E{(u16*)(P.ws + WS_HBUF)};
    pg::gemm_phase((LAS unsigned char*)lds, S, E, DM);
}

DI void phase_ln1_router(const Params& P, char* lds) {
    int tidv = threadIdx.x;
    asm volatile("" : "+v"(tidv));
    const int tid = tidv, lane = tid & 63, wid = __builtin_amdgcn_readfirstlane(tid >> 6);
    const u16* hbuf = (const u16*)(P.ws + WS_HBUF);
    float* x1f = (float*)(P.ws + WS_X1F);
    u16* x1b = (u16*)(P.ws + WS_X1B);
    const u16* wr_hi = (const u16*)(P.ws + WS_WRT); const u16* wr_lo = wr_hi + 80 * 1024;
    int* cnt = (int*)(P.ws + WS_CNT);
    int* ltok = (int*)(P.ws + WS_LTOK);
    float* lgate = (float*)(P.ws + WS_LGATE);
    float* part = (float*)lds;
    float* lg = (float*)(lds + 81920);
    int* rE1 = (int*)(lds + 102400); int* rE2 = rE1 + 64; int* rR1 = rE1 + 128; int* rR2 = rE1 + 192; int* hist = rE1 + 256; int* rbase = rE1 + 320;
    float* rG1 = (float*)(rE1 + 384); float* rG2 = rG1 + 64;
    for (int g = blockIdx.x; g < NTOK / 64; g += gridDim.x) {
        const int row0 = g * 64;
        if (tid < 64) hist[tid] = 0;
        uint2 hv[2][4]; float4 xv[2][4];
#define LN_FETCH(r_) do { _Pragma("unroll") for (int rr = 0; rr < 2; ++rr) { const size_t rb_ = (size_t)((r_) + rr) * DM + lane * 4; \
        _Pragma("unroll") for (int j = 0; j < 4; ++j) { { const u32x2_t hh = __builtin_nontemporal_load((const u32x2_t*)(hbuf + rb_ + 256 * j)); hv[rr][j] = make_uint2(hh.x, hh.y); } xv[rr][j] = ldnt4(P.x + rb_ + 256 * j); } } } while (0)
        LN_FETCH(row0 + wid * 8);
#pragma unroll 1
        for (int it = 0; it < 4; ++it) {
            float4 v[2][4];
#pragma unroll
            for (int rr = 0; rr < 2; ++rr)
#pragma unroll
                for (int j = 0; j < 4; ++j) v[rr][j] = make_float4(ALPHA * xv[rr][j].x + bflo(hv[rr][j].x), ALPHA * xv[rr][j].y + bfhi(hv[rr][j].x), ALPHA * xv[rr][j].z + bflo(hv[rr][j].y), ALPHA * xv[rr][j].w + bfhi(hv[rr][j].y));
            if (it < 3) LN_FETCH(row0 + wid * 8 + 2 * (it + 1));
#pragma unroll
            for (int rr = 0; rr < 2; ++rr) {
                const size_t rbase_ = (size_t)(row0 + wid * 8 + 2 * it + rr) * DM;
                float s = 0.f;
#pragma unroll
                for (int j = 0; j < 4; ++j) s += v[rr][j].x + v[rr][j].y + v[rr][j].z + v[rr][j].w;
                const float mu = wave_sum(s) * (1.f / 1024.f);
                float q = 0.f;
#pragma unroll
                for (int j = 0; j < 4; ++j) { const float a = v[rr][j].x - mu, b2 = v[rr][j].y - mu, c2 = v[rr][j].z - mu, d2 = v[rr][j].w - mu; q += a * a + b2 * b2 + c2 * c2 + d2 * d2; }
                const float rstd = rsqrtf(wave_sum(q) * (1.f / 1024.f) + 1e-5f);
#pragma unroll
                for (int j = 0; j < 4; ++j) {
                    const int col = lane * 4 + 256 * j;
                    const float4 gg = *(const float4*)(P.ln1_g + col), bb = *(const float4*)(P.ln1_b + col);
                    float4 o;
                    o.x = (v[rr][j].x - mu) * rstd * gg.x + bb.x; o.y = (v[rr][j].y - mu) * rstd * gg.y + bb.y;
                    o.z = (v[rr][j].z - mu) * rstd * gg.z + bb.z; o.w = (v[rr][j].w - mu) * rstd * gg.w + bb.w;
                    *(float4*)(x1f + rbase_ + col) = o;
                    *(uint2*)(x1b + rbase_ + col) = make_uint2(pack2(o.x, o.y), pack2(o.z, o.w));
                }
            }
        }
#undef LN_FETCH
        asm volatile("s_waitcnt vmcnt(0)" ::: "memory");
        __syncthreads();
        {
            f32x4 acc[2][5];
#pragma unroll
            for (int mt = 0; mt < 2; ++mt)
#pragma unroll
                for (int n = 0; n < 5; ++n) acc[mt][n] = f32x4{0.f, 0.f, 0.f, 0.f};
            const int mh = wid & 1, kq = wid >> 1, m = lane & 15, kg = lane >> 4;
            const float* ap = x1f + (size_t)(row0 + 32 * mh + m) * DM + 256 * kq + 8 * kg;
            const u16* bhp = wr_hi + (size_t)m * 1024 + 256 * kq + 8 * kg; const u16* blp = wr_lo + (size_t)m * 1024 + 256 * kq + 8 * kg;
#pragma unroll 2
            for (int ks = 0; ks < 8; ++ks) {
                bf16x8 bh[5], bl[5];
#pragma unroll
                for (int n = 0; n < 5; ++n) { bh[n] = ld_frag((const char*)(bhp + n * 16384 + 32 * ks)); bl[n] = ld_frag((const char*)(blp + n * 16384 + 32 * ks)); }
#pragma unroll
                for (int mt = 0; mt < 2; ++mt) {
                    const float4 f0 = *(const float4*)(ap + (size_t)mt * 16 * DM + 32 * ks), f1 = *(const float4*)(ap + (size_t)mt * 16 * DM + 32 * ks + 4);
                    const float f[8] = {f0.x, f0.y, f0.z, f0.w, f1.x, f1.y, f1.z, f1.w};
                    unsigned hi[4], lo[4];
#pragma unroll
                    for (int q = 0; q < 4; ++q) { hi[q] = pack2(f[2 * q], f[2 * q + 1]); lo[q] = pack2(f[2 * q] - bflo(hi[q]), f[2 * q + 1] - bfhi(hi[q])); }
                    const u32x4 hv4 = {hi[0], hi[1], hi[2], hi[3]}, lv4 = {lo[0], lo[1], lo[2], lo[3]};
                    const bf16x8 ah = __builtin_bit_cast(bf16x8, hv4), alo = __builtin_bit_cast(bf16x8, lv4);
#pragma unroll
                    for (int n = 0; n < 5; ++n) { acc[mt][n] = mfma16(ah, bh[n], acc[mt][n]); acc[mt][n] = mfma16(ah, bl[n], acc[mt][n]); acc[mt][n] = mfma16(alo, bh[n], acc[mt][n]); }
                }
            }
#pragma unroll
            for (int mt = 0; mt < 2; ++mt)
#pragma unroll
                for (int n = 0; n < 5; ++n)
#pragma unroll
                    for (int i = 0; i < 4; ++i) part[(kq * 64 + 32 * mh + 16 * mt + 4 * kg + i) * 80 + n * 16 + m] = acc[mt][n][i];
        }
        __syncthreads();
        for (int idx = tid; idx < 64 * 80; idx += 512) {
            const int cc = idx % 80;
            float s = part[idx] + part[5120 + idx] + part[10240 + idx] + part[15360 + idx];
            if (cc < 8) s += P.b_rg[cc]; else if (cc < 72) s += P.b_re[cc - 8];
            lg[idx] = s;
        }
        __syncthreads();
        if (tid < 64) {
            const float* L = lg + tid * 80;
            float mx = L[0]; int gs = 0;
#pragma unroll
            for (int q = 1; q < 8; ++q) { const float v = L[q]; if (v > mx) { mx = v; gs = q; } }
            float den = 0.f;
#pragma unroll
            for (int q = 0; q < 8; ++q) den += __expf(L[q] - mx);
            const float pgroup = 1.f / den;
            const float* E = L + 8 + gs * 8;
            float l1 = E[0]; int e1 = 0;
#pragma unroll
            for (int j = 1; j < 8; ++j) { const float v = E[j]; if (v > l1) { l1 = v; e1 = j; } }
            float l2 = -3.0e38f; int e2 = 0;
#pragma unroll
            for (int j = 0; j < 8; ++j) { const float v = E[j]; if (j != e1 && v > l2) { l2 = v; e2 = j; } }
            const float ex = __expf(l2 - l1);
            const float w1 = 1.f / (1.f + ex), w2 = ex / (1.f + ex);
            const int E1 = gs * 8 + e1, E2 = gs * 8 + e2;
            rE1[tid] = E1; rE2[tid] = E2; rG1[tid] = pgroup * w1; rG2[tid] = pgroup * w2;
            rR1[tid] = atomicAdd(&hist[E1], 1); rR2[tid] = atomicAdd(&hist[E2], 1);
        }
        __syncthreads();
        if (tid < 64) { const int h = hist[tid]; rbase[tid] = h > 0 ? atomicAdd(&cnt[tid], h) : 0; }
        __syncthreads();
        if (tid < 64) {
            const int E1 = rE1[tid], E2 = rE2[tid];
            const int p1 = rbase[E1] + rR1[tid], p2 = rbase[E2] + rR2[tid];
            ltok[E1 * 16384 + p1] = (row0 + tid) * 2; lgate[E1 * 16384 + p1] = rG1[tid];
            ltok[E2 * 16384 + p2] = (row0 + tid) * 2 + 1; lgate[E2 * 16384 + p2] = rG2[tid];
        }
        __syncthreads();
    }
}

constexpr int MOE_TAB = 131072, MOE_LIST = 131072 + 1024, MOE_ROWS = 131072 + 4096, MOE_GATE = MOE_ROWS + 8192;
DI int moe_build_table(const Params& P, char* lds) {
    int* tab = (int*)(lds + MOE_TAB); u16* plist = (u16*)(lds + MOE_LIST);
    const int* cnt = (const int*)(P.ws + WS_CNT);
    const int x = blockIdx.x & 7;
    if (threadIdx.x < 64) {
        const int e = threadIdx.x, c = cnt[e], nrb = (c + 255) >> 8;
        const bool mine = (e & 7) == x;
        const int tail = (mine && nrb > 0 && (c - (nrb - 1) * 256) <= 128) ? 1 : 0, full = mine ? nrb - tail : 0;
        const int ho_incl = (int)wave_scan_incl((float)(nrb * 256)), fu_incl = (int)wave_scan_incl((float)full), ta_incl = (int)wave_scan_incl((float)tail);
        const int nfull = __builtin_amdgcn_readlane(fu_incl, 63), ntail = __builtin_amdgcn_readlane(ta_incl, 63);
        tab[e] = c; tab[64 + e] = ho_incl - nrb * 256;
        const int p = fu_incl - full;
        for (int rb = 0; rb < full; ++rb) plist[p + rb] = (u16)((e << 8) | rb);
        if (tail) plist[nfull + ta_incl - 1] = (u16)((e << 8) | (nrb - 1));
        if (e == 0) tab[129] = nfull + ntail;
    }
    __syncthreads();
    return tab[129] * 4;
}
struct MoeSched {
    struct Unit { int e, rb, ns, slot, nvalid, hrow0; };
    static DI bool half1_empty(const Unit& u) { return u.nvalid <= 128; }
    const int* tab; const u16* plist; const int* rows;
    const char* A; const char* Bt; int nunits, G8, c8, base; bool down;
    DI bool next(int i, Unit& u) const {
        if (i >= 8) return false;
        const int L = (base + i) * G8 + c8; if (L >= nunits) return false;
        const int pr = plist[L >> 2];
        u.e = pr >> 8; u.rb = pr & 255; u.ns = L & 3; u.slot = i;
        u.nvalid = min(256, tab[u.e] - u.rb * 256); u.hrow0 = tab[64 + u.e] + u.rb * 256;
        return true;
    }
    DI void addr(const Unit& u, const int (&R)[2], const int (&C)[2], const char*& aBase, unsigned (&vA)[2][2], const char*& bBase) const {
        if (!down) {
            aBase = A; bBase = Bt + (size_t)(u.e * 4 + u.ns) * 256 * 1024 * 2;
#pragma unroll
            for (int h = 0; h < 2; ++h)
#pragma unroll
                for (int i = 0; i < 2; ++i) vA[h][i] = (unsigned)(rows[u.slot * 256 + h * 128 + R[i]] * 1024 + C[i]) * 2u;
        } else {
            aBase = A + (size_t)u.hrow0 * 512 * 2; bBase = Bt + ((size_t)u.e * 1024 + u.ns * 256) * 512 * 2;
#pragma unroll
            for (int h = 0; h < 2; ++h)
#pragma unroll
                for (int i = 0; i < 2; ++i) vA[h][i] = (unsigned)((h * 128 + R[i]) * 512 + C[i]) * 2u;
        }
    }
};
struct EpiMoeUp {
    u16* H;
    DI void operator()(const pg::f32x4 (&acc)[2][2][4][2], const MoeSched::Unit& u, int wr, int wc, int fr, int fq) const {
        const int col0 = u.ns * 128 + wc * 32 + 8 * fq;
#pragma unroll
        for (int ai = 0; ai < 2; ++ai)
#pragma unroll
            for (int m = 0; m < 4; ++m) {
                const int rl = ai * 128 + wr * 64 + m * 16 + fr;
                if (rl < u.nvalid) {
                    const pg::f32x4 g0 = acc[ai][0][m][0], g1 = acc[ai][0][m][1], u0 = acc[ai][1][m][0], u1 = acc[ai][1][m][1];
                    *(uint4*)(H + (size_t)(u.hrow0 + rl) * 512 + col0) =
                        make_uint4(pack2(silu_f(g0[0]) * u0[0], silu_f(g0[1]) * u0[1]), pack2(silu_f(g0[2]) * u0[2], silu_f(g0[3]) * u0[3]),
                                   pack2(silu_f(g1[0]) * u1[0], silu_f(g1[1]) * u1[1]), pack2(silu_f(g1[2]) * u1[2], silu_f(g1[3]) * u1[3]));
                }
            }
    }
};
struct EpiMoeDown {
    u16* ys; const int* meta; const float* gate;
    DI void operator()(const pg::f32x4 (&acc)[2][2][4][2], const MoeSched::Unit& u, int wr, int wc, int fr, int fq) const {
        const int col0 = u.ns * 256 + wc * 32 + 8 * fq;
#pragma unroll
        for (int ai = 0; ai < 2; ++ai)
#pragma unroll
            for (int m = 0; m < 4; ++m) {
                const int rl = ai * 128 + wr * 64 + m * 16 + fr;
                const int mt = meta[u.slot * 256 + rl]; const float gt = gate[u.slot * 256 + rl];
                if (mt >= 0) {
                    u16* dst = ys + ((size_t)(mt & 1) * NTOK + (mt >> 1)) * DM + col0;
#pragma unroll
                    for (int bj = 0; bj < 2; ++bj) {
                        const pg::f32x4 v0 = acc[ai][bj][m][0], v1 = acc[ai][bj][m][1];
                        *(uint4*)(dst + bj * 128) = make_uint4(pack2(gt * v0[0], gt * v0[1]), pack2(gt * v0[2], gt * v0[3]), pack2(gt * v1[0], gt * v1[1]), pack2(gt * v1[2], gt * v1[3]));
                    }
                }
            }
    }
};
DI void phase_moe(const Params& P, char* lds, bool down) {
    const int tid = threadIdx.x;
    const int nunits = moe_build_table(P, lds);
    const int* tab = (const int*)(lds + MOE_TAB);
    int* rows = (int*)(lds + MOE_ROWS); float* gts = (float*)(lds + MOE_GATE);
    const int* ltok = (const int*)(P.ws + WS_LTOK);
    const float* lgate = (const float*)(P.ws + WS_LGATE);
    const int G8 = gridDim.x >> 3, c8 = blockIdx.x >> 3;
    for (int base = 0; base * G8 + c8 < nunits; base += 8) {
        MoeSched S{tab, (const u16*)(lds + MOE_LIST), rows, down ? (const char*)(P.ws + WS_H) : (const char*)(P.ws + WS_X1B), down ? (const char*)(P.ws + WS_WD) : (const char*)(P.ws + WS_WGU), nunits, G8, c8, base, down};
        for (int i = 0; i < 8; ++i) {
            MoeSched::Unit u;
            if (!S.next(i, u)) break;
            if (tid < 256) {
                const bool ok = tid < u.nvalid;
                const int mt = ok ? ltok[u.e * 16384 + u.rb * 256 + tid] : -1;
                rows[i * 256 + tid] = down ? mt : (ok ? (mt >> 1) : 0);
                if (down) gts[i * 256 + tid] = ok ? lgate[u.e * 16384 + u.rb * 256 + tid] : 0.f;
            }
        }
        __syncthreads();
        if (!down) { EpiMoeUp E{(u16*)(P.ws + WS_H)}; pg::gemm_phase((LAS unsigned char*)lds, S, E, 1024); }
        else { EpiMoeDown E{(u16*)(P.ws + WS_YS), rows, gts}; pg::gemm_phase((LAS unsigned char*)lds, S, E, 512); }
        __syncthreads();
    }
}

DI void phase_ln2(const Params& P) {
    const int tid = threadIdx.x, lane = tid & 63, wid = tid >> 6;
    const float* x1f = (const float*)(P.ws + WS_X1F);
    const u16* ys = (const u16*)(P.ws + WS_YS);
    for (int row = blockIdx.x * 8 + wid; row < NTOK; row += gridDim.x * 8) {
        const size_t rbase = (size_t)row * DM;
        float4 v[4];
#pragma unroll
        for (int j = 0; j < 4; ++j) {
            const int col = lane * 4 + 256 * j;
            const float4 xv = ldnt4(x1f + rbase + col);
            const uint2 a = *(const uint2*)(ys + rbase + col), b2 = *(const uint2*)(ys + (size_t)NTOK * DM + rbase + col);
            v[j].x = ALPHA * xv.x + bflo(a.x) + bflo(b2.x); v[j].y = ALPHA * xv.y + bfhi(a.x) + bfhi(b2.x);
            v[j].z = ALPHA * xv.z + bflo(a.y) + bflo(b2.y); v[j].w = ALPHA * xv.w + bfhi(a.y) + bfhi(b2.y);
        }
        float s = 0.f;
#pragma unroll
        for (int j = 0; j < 4; ++j) s += v[j].x + v[j].y + v[j].z + v[j].w;
        const float mu = wave_sum(s) * (1.f / 1024.f);
        float q = 0.f;
#pragma unroll
        for (int j = 0; j < 4; ++j) { const float a = v[j].x - mu, b2 = v[j].y - mu, c2 = v[j].z - mu, d2 = v[j].w - mu; q += a * a + b2 * b2 + c2 * c2 + d2 * d2; }
        const float rstd = rsqrtf(wave_sum(q) * (1.f / 1024.f) + 1e-5f);
#pragma unroll
        for (int j = 0; j < 4; ++j) {
            const int col = lane * 4 + 256 * j;
            const float4 g = *(const float4*)(P.ln2_g + col), bb = *(const float4*)(P.ln2_b + col);
            float4 o;
            o.x = (v[j].x - mu) * rstd * g.x + bb.x; o.y = (v[j].y - mu) * rstd * g.y + bb.y;
            o.z = (v[j].z - mu) * rstd * g.z + bb.z; o.w = (v[j].w - mu) * rstd * g.w + bb.w;
            stnt4(P.out + rbase + col, o);
        }
    }
}

__global__ void __launch_bounds__(512, 2) fwd_kernel(Params P) {
    extern __shared__ __attribute__((aligned(16))) char lds[];
    volatile LAS unsigned* xbw = (volatile LAS unsigned*)(lds + LDS_BYTES - 16);
    const int lo = P.ph_lo, hi = P.ph_hi;
    XcdBarrier bar;
    if (hi - lo > 1) {
        if (threadIdx.x == 0) { xbw[0] = 0u; xbw[1] = 0u; xbw[2] = 0u; xbw[3] = 0u; }
        __syncthreads();
        bar = xcd_barrier_post((unsigned*)(P.ws + WS_BAR), xbw);
    }
#define IN(k) (lo <= (k) && (k) < hi)
#define SEAM(k) do { if (IN(k) && IN((k) + 1)) xcd_barrier(bar); } while (0)
#define RUN(k, call) do { if (IN(k)) { call; if (REPEAT_PHASE == (k)) { xcd_barrier(bar); \
        if ((k) == 5) { if (blockIdx.x == 0 && threadIdx.x < 64) ((int*)(P.ws + WS_CNT))[threadIdx.x] = 0; xcd_barrier(bar); } call; } } } while (0)
    RUN(0, phase_convert(P));
    SEAM(0);
    RUN(1, phase_inproj(P, lds));
    SEAM(1);
    RUN(2, phase_prep(P, lds));
    SEAM(2);
    RUN(3, phase_scan(P, lds));
    SEAM(3);
    RUN(4, phase_outproj(P, lds));
    SEAM(4);
    RUN(5, phase_ln1_router(P, lds));
    SEAM(5);
    RUN(6, phase_moe(P, lds, false));
    SEAM(6);
    RUN(7, phase_moe(P, lds, true));
    SEAM(7);
    RUN(8, phase_ln2(P));
#undef RUN
#undef IN
#undef SEAM
}

extern "C" void kernel_launch(void* const* d_in, const int* in_sizes, int n_in, void* d_out, int out_size, void* d_ws, size_t ws_size, hipStream_t stream) {
    static int grid = 0;
    if (grid == 0) {
        if (n_in != 21 || in_sizes[0] != NTOK * DM || out_size != NTOK * DM || ws_size < WS_END) {
            fprintf(stderr, "kernel_launch: unexpected shapes (n_in %d, in0 %d, out %d, ws %zu); nothing launched\n", n_in, n_in > 0 ? in_sizes[0] : -1, out_size, ws_size);
            grid = -1; return;
        }
        int dev = 0, cus = 0;
        if (hipGetDevice(&dev) != hipSuccess || hipDeviceGetAttribute(&cus, hipDeviceAttributeMultiprocessorCount, dev) != hipSuccess) { grid = -1; return; }
        if (hipFuncSetAttribute((const void*)fwd_kernel, hipFuncAttributeMaxDynamicSharedMemorySize, LDS_BYTES) != hipSuccess) { fprintf(stderr, "kernel_launch: hipFuncSetAttribute failed\n"); grid = -1; return; }
        int per_cu = 0;
        if (hipOccupancyMaxActiveBlocksPerMultiprocessor(&per_cu, (const void*)fwd_kernel, 512, LDS_BYTES) != hipSuccess || per_cu < 1)
            fprintf(stderr, "kernel_launch: occupancy query reports %d blocks per CU\n", per_cu);
        (void)hipGetLastError();
        grid = cus & ~7;
    }
    if (grid < 0) return;
    (void)hipMemsetAsync(d_ws, 0, 16384 + 1024, stream);
    Params p{};
    const float** pf = (const float**)&p;
    for (int i = 0; i < 21; ++i) pf[i] = (const float*)d_in[i];
    p.out = (float*)d_out; p.ws = (unsigned char*)d_ws;
#if MK_N_LAUNCHES == 1
    p.ph_lo = 0; p.ph_hi = NPHASE;
    hipLaunchKernelGGL(fwd_kernel, dim3(grid), dim3(512), LDS_BYTES, stream, p);
#else
    for (int k = 0; k < NPHASE; ++k) {
        p.ph_lo = k; p.ph_hi = k + 1;
        hipLaunchKernelGGL(fwd_kernel, dim3(grid), dim3(512), LDS_BYTES, stream, p);
    }
#endif
}
```

```cpp
#include <hip/hip_runtime.h>
#include <stdint.h>
#include <stdio.h>
#include <type_traits>

#ifndef MK_N_LAUNCHES
#define MK_N_LAUNCHES 1
#endif

#ifndef REPEAT_PHASE
#define REPEAT_PHASE (-1)
#endif

#define DI __device__ __forceinline__
typedef unsigned short u16;
using bf16x8 = __attribute__((ext_vector_type(8))) __bf16;
using f32x16 = __attribute__((ext_vector_type(16))) float;
using f32x4  = __attribute__((ext_vector_type(4))) float;
using u32x4  = __attribute__((ext_vector_type(4))) unsigned;

constexpr int NTOK = 16384, DM = 1024, SEQ = 2048, NCH = 32;
constexpr int PLD = 3584;
constexpr int C_QA = 0, C_KA = 256, C_VA = 512, C_RA = 1024, C_QB = 1536, C_KB = 2048, C_VB = 2560, C_ZB = 3072;
constexpr int WIN_LD = 3608;
constexpr float ALPHA = 1.189207115002721f;
constexpr int NPHASE = 9;

constexpr size_t MB = 1024 * 1024;
constexpr size_t WS_BAR = 0;
constexpr size_t WS_CNT = 16384;
constexpr size_t WS_WRT = 32768;
constexpr size_t WS_SMALL = 512 * 1024;
constexpr size_t WS_DL = 3 * MB;
constexpr size_t WS_PROJ = 4 * MB;
constexpr size_t WS_YS = 4 * MB;
constexpr size_t WS_X1F = 68 * MB;
constexpr size_t WS_GDN = 116 * MB;
constexpr size_t GDN_UNIT = 73728;
constexpr size_t WS_HBUF = 132 * MB;
constexpr size_t WS_GLA = 188 * MB;
constexpr size_t GLA_UNIT = 24832;
constexpr size_t WS_H = 196 * MB;
constexpr size_t WS_MIXED = 214 * MB;
constexpr size_t WS_WGU = 246 * MB;
constexpr size_t WS_WD = 374 * MB;
constexpr size_t WS_XB = 438 * MB;
constexpr size_t WS_X1B = 438 * MB;
constexpr size_t WS_WINT = 470 * MB;
constexpr size_t WS_WOUTT = 478 * MB;
constexpr size_t WS_LTOK = 480 * MB;
constexpr size_t WS_LGATE = 484 * MB;
constexpr size_t WS_END = 488 * MB;

constexpr int LDS_BYTES = 155648;

struct Params {
    const float *x, *w_in, *w_gk_up, *b_gk, *conv_w, *a_log, *dt_bias, *gla_g, *gdn_g, *w_out, *ln1_g, *ln1_b;
    const float *w_rg, *b_rg, *w_re, *b_re, *w_gate, *w_up, *w_down, *ln2_g, *ln2_b;
    float* out;
    unsigned char* ws;
    int ph_lo, ph_hi;
};

DI u16 f2bf(float x) { return __builtin_bit_cast(u16, (__bf16)x); }
DI float bf2f(u16 v) { return __uint_as_float(((unsigned)v) << 16); }
typedef __bf16 bf16x2_t __attribute__((ext_vector_type(2)));
typedef float f32x2_t __attribute__((ext_vector_type(2)));
typedef unsigned u32x2_t __attribute__((ext_vector_type(2)));
DI unsigned pack2(float a, float b) { const f32x2_t v = {a, b}; return __builtin_bit_cast(unsigned, __builtin_convertvector(v, bf16x2_t)); }
DI float bflo(unsigned v) { return __uint_as_float(v << 16); }
DI float bfhi(unsigned v) { return __uint_as_float(v & 0xffff0000u); }
DI int crow(int i, int h) { return (i & 3) + 8 * (i >> 2) + 4 * h; }
DI float silu_f(float x) { return x / (1.f + __expf(-x)); }
DI f32x16 mfma32(bf16x8 a, bf16x8 b, f32x16 c) { return __builtin_amdgcn_mfma_f32_32x32x16_bf16(a, b, c, 0, 0, 0); }
DI f32x4 mfma16(bf16x8 a, bf16x8 b, f32x4 c) { return __builtin_amdgcn_mfma_f32_16x16x32_bf16(a, b, c, 0, 0, 0); }
DI bf16x8 ld_frag(const char* p) { return __builtin_bit_cast(bf16x8, *(const u32x4*)p); }
DI bf16x8 ld_frag_perm(const char* rowp, int ks, int h) {
    const char* p = rowp + (16 * ks + 4 * h) * 2;
    uint2 lo = *(const uint2*)p, hi = *(const uint2*)(p + 16);
    u32x4 v = {lo.x, lo.y, hi.x, hi.y};
    return __builtin_bit_cast(bf16x8, v);
}
template <int N, int I = 0, class F> DI void static_for(F&& f) {
    if constexpr (I < N) { f(std::integral_constant<int, I>{}); static_for<N, I + 1>(f); }
}
DI bf16x8 ld_frag2(const char* p) {
    const uint2 lo = *(const uint2*)p, hi = *(const uint2*)(p + 16);
    const u32x4 v = {lo.x, lo.y, hi.x, hi.y};
    return __builtin_bit_cast(bf16x8, v);
}
template <int S> DI bf16x8 pack8(const f32x16& x) {
    u32x4 v = {pack2(x[8 * S], x[8 * S + 1]), pack2(x[8 * S + 2], x[8 * S + 3]), pack2(x[8 * S + 4], x[8 * S + 5]), pack2(x[8 * S + 6], x[8 * S + 7])};
    return __builtin_bit_cast(bf16x8, v);
}
DI float dpp_row_shr(float v, int n) {
    const int iv = __builtin_bit_cast(int, v); int r;
    switch (n) { case 1: r = __builtin_amdgcn_update_dpp(0, iv, 0x111, 0xf, 0xf, true); break; case 2: r = __builtin_amdgcn_update_dpp(0, iv, 0x112, 0xf, 0xf, true); break;
                 case 4: r = __builtin_amdgcn_update_dpp(0, iv, 0x114, 0xf, 0xf, true); break; default: r = __builtin_amdgcn_update_dpp(0, iv, 0x118, 0xf, 0xf, true); break; }
    return __builtin_bit_cast(float, r);
}
DI float wave_scan_incl(float v) {
    v += dpp_row_shr(v, 1); v += dpp_row_shr(v, 2); v += dpp_row_shr(v, 4); v += dpp_row_shr(v, 8);
    v += __builtin_bit_cast(float, __builtin_amdgcn_update_dpp(0, __builtin_bit_cast(int, v), 0x142, 0xa, 0xf, false));
    v += __builtin_bit_cast(float, __builtin_amdgcn_update_dpp(0, __builtin_bit_cast(int, v), 0x143, 0xc, 0xf, false));
    return v;
}
DI uint4 ldnt_u4(const void* p) { const u32x4 v = __builtin_nontemporal_load((const u32x4*)p); return make_uint4(v.x, v.y, v.z, v.w); }
DI float4 ldnt4(const float* p) { const f32x4 v = __builtin_nontemporal_load((const f32x4*)p); return make_float4(v.x, v.y, v.z, v.w); }
DI void stnt4(float* p, float4 v) { __builtin_nontemporal_store(f32x4{v.x, v.y, v.z, v.w}, (f32x4*)p); }
DI float wave_sum(float v) {
#pragma unroll
    for (int o = 32; o > 0; o >>= 1) v += __shfl_xor(v, o, 64);
    return v;
}

#define XB_TMO      128
#define XB_XCNT(j)  (256  + 64 * (j))
#define XB_XSUB(j)  (1280 + 64 * (j))
#define XB_XGEN(j)  (2304 + 64 * (j))
#define XB_TOP      3328
#define XB_TOPGEN   3392
#define XCD_BAR_WORDS 3456
#define XB_SPIN_CAP (1u << 18)
#define LAS __attribute__((address_space(3)))

__device__ __forceinline__ unsigned xb_ld(unsigned* p)              { return __hip_atomic_load(p, __ATOMIC_RELAXED, __HIP_MEMORY_SCOPE_AGENT); }
__device__ __forceinline__ unsigned xb_add(unsigned* p, unsigned v) { return __hip_atomic_fetch_add(p, v, __ATOMIC_RELAXED, __HIP_MEMORY_SCOPE_AGENT); }
__device__ __forceinline__ unsigned xb_xcc_id() { return (unsigned)__builtin_amdgcn_s_getreg((3 << 11) | 20) & 0xFu; }
#define XB_SPIN(cond, bar) do { unsigned _sp = 0; while (cond) { __builtin_amdgcn_s_sleep(1); \
    if ((++_sp & 255u) == 0u) { if (xb_ld(&(bar)[XB_TMO])) break; if (_sp > XB_SPIN_CAP) { atomicAdd(&(bar)[XB_TMO], 1u); break; } } } } while (0)

struct XcdBarrier {
    unsigned* bar; unsigned x;
    volatile LAS unsigned* st;
};
__device__ __forceinline__ XcdBarrier xcd_barrier_post(unsigned* bar, volatile LAS unsigned* st) {
    XcdBarrier b; b.bar = bar; b.x = xb_xcc_id(); b.st = st;
    if (threadIdx.x == 0) (void)xb_add(&bar[XB_XCNT(b.x)], 1u);
    return b;
}
__device__ __forceinline__ void xcd_barrier_complete(unsigned* bar, unsigned x, unsigned& nloc, unsigned& nx) {
    const unsigned G = gridDim.x * gridDim.y * gridDim.z;
    unsigned sum, cnt, mine, sp = 0u;
    for (;;) {
        sum = 0u; cnt = 0u; mine = 0u;
#pragma unroll
        for (unsigned j = 0; j < 16; ++j) { const unsigned c = xb_ld(&bar[XB_XCNT(j)]); sum += c; cnt += (c > 0u) ? 1u : 0u; mine = (j == x) ? c : mine; }
        if (sum == G) break;
        __builtin_amdgcn_s_sleep(1);
        if ((++sp & 255u) == 0u) { if (xb_ld(&bar[XB_TMO])) break; if (sp > XB_SPIN_CAP) { atomicAdd(&bar[XB_TMO], 1u); break; } }
    }
    nloc = mine > 0u ? mine : 1u; nx = cnt > 0u ? cnt : 1u;
}
__device__ __forceinline__ void xcd_barrier(const XcdBarrier& b) {
    asm volatile("s_waitcnt vmcnt(0)" ::: "memory");
    __syncthreads();
    if (threadIdx.x == 0) {
        unsigned* bar = b.bar;
        __builtin_amdgcn_s_waitcnt(0);
        unsigned nloc = b.st[0], nx = b.st[1];
        if (nloc == 0u) { xcd_barrier_complete(bar, b.x, nloc, nx); b.st[0] = nloc; b.st[1] = nx; }
        const unsigned old = xb_add(&bar[XB_XSUB(b.x)], 1u);
        const unsigned gen = old / nloc;
        if (old + 1u == (gen + 1u) * nloc) {
            __builtin_amdgcn_fence(__ATOMIC_RELEASE, "agent");
            asm volatile("s_waitcnt vmcnt(0)" ::: "memory");
            const unsigned og = xb_add(&bar[XB_TOP], 1u);
            const unsigned tg = og / nx;
            if (og + 1u == (tg + 1u) * nx) xb_add(&bar[XB_TOPGEN], 1u);
            else XB_SPIN(xb_ld(&bar[XB_TOPGEN]) == tg, bar);
            __builtin_amdgcn_fence(__ATOMIC_ACQUIRE, "agent");
            xb_add(&bar[XB_XGEN(b.x)], 1u);
            asm volatile("s_waitcnt vmcnt(0)" ::: "memory");
        } else {
            XB_SPIN(xb_ld(&bar[XB_XGEN(b.x)]) == gen, bar);
            __builtin_amdgcn_fence(__ATOMIC_ACQUIRE, "agent");
            asm volatile("s_waitcnt vmcnt(0)" ::: "memory");
        }
    }
    __syncthreads();
}

namespace pg {
typedef float f32x4 __attribute__((ext_vector_type(4)));
typedef short s16x8 __attribute__((ext_vector_type(8)));
constexpr int BK = 64, HALF = 128, HTB = HALF * BK * 2, STAGE_BYTES = 8 * HTB;
DI int lds_byte(int r, int c) { const int st = (r >> 4) * 2 + (c >> 5), rr = r & 15, cc = c & 31, ob = rr * 64 + cc * 2; return st * 1024 + (ob ^ (((ob >> 9) & 1) << 5)); }
DI void stage_rc(int b, int& R, int& C) { const int st = b / 1024, sb = b % 1024, swz = sb ^ (((sb >> 9) & 1) << 5); R = (st >> 1) * 16 + swz / 64; C = (st & 1) * 32 + (swz % 64) / 2; }
DI int perm32(int rho) { const int n = rho >> 4, i = rho & 15; return 8 * (i >> 2) + 4 * n + (i & 3); }

template <class Epi, class Sched>
DI void gemm_phase(LAS unsigned char* lds, const Sched& S, const Epi& E, const int K) {
    const int tid = threadIdx.x, wid = __builtin_amdgcn_readfirstlane(tid >> 6), lane = tid & 63, wr = wid >> 2, wc = wid & 3, fr = lane & 15, fq = lane >> 4;
    const int nt = K / BK;
    int RA[2], CA[2]; unsigned voffB[2];
#pragma unroll
    for (int i = 0; i < 2; ++i) { int R, C; stage_rc(tid * 16 + i * 8192, R, C); RA[i] = R; CA[i] = C; const int Rb = (R & ~31) + perm32(R & 31); voffB[i] = (unsigned)(Rb * K + C) * 2u; }
    const size_t kstep = (size_t)(BK * 2);
    const size_t hstepB = (size_t)HALF * K * 2;
    const unsigned ldsw = (unsigned)wid * 1024u;
    const int aoff = lds_byte(wr * 64 + fr, fq * 8), boff = lds_byte(wc * 32 + fr, fq * 8);
#define PG_SA(b, h) (((b) * 2 + (h)) * HTB)
#define PG_SB(b, h) ((4 + (b) * 2 + (h)) * HTB)
#define PG_STAGE(bufoff, gbase, voff) do { _Pragma("unroll") for (int _i = 0; _i < 2; ++_i) \
        __builtin_amdgcn_global_load_lds((const unsigned*)((const char*)(gbase) + (voff)[_i]), (LAS unsigned*)(lds + (bufoff) + ldsw + _i * 8192), 16, 0, 0); } while (0)
#define PG_LDA(dst, b, h) do { _Pragma("unroll") for (int m = 0; m < 4; ++m) _Pragma("unroll") for (int k = 0; k < 2; ++k) dst[m][k] = *(const LAS s16x8*)(lds + PG_SA(b, h) + aoff + m * 2048 + k * 1024); } while (0)
#define PG_LDB(dst, b, h) do { _Pragma("unroll") for (int n = 0; n < 2; ++n) _Pragma("unroll") for (int k = 0; k < 2; ++k) dst[n][k] = *(const LAS s16x8*)(lds + PG_SB(b, h) + boff + n * 2048 + k * 1024); } while (0)
#define PG_MMA(ai, bj, At, Bt) do { if ((ai) == 1 && skip1) break; __builtin_amdgcn_s_setprio(1); _Pragma("unroll") for (int m = 0; m < 4; ++m) _Pragma("unroll") for (int n = 0; n < 2; ++n) _Pragma("unroll") for (int k = 0; k < 2; ++k) \
        acc[ai][bj][m][n] = __builtin_amdgcn_mfma_f32_16x16x32_bf16(__builtin_bit_cast(bf16x8, Bt[n][k]), __builtin_bit_cast(bf16x8, At[m][k]), acc[ai][bj][m][n], 0, 0, 0); __builtin_amdgcn_s_setprio(0); } while (0)
#define PG_WAIT_V(n) asm volatile("s_waitcnt vmcnt(" #n ")" ::: "memory")
#define PG_WAIT_L(n) asm volatile("s_waitcnt lgkmcnt(" #n ")" ::: "memory")
#define PG_BAR __builtin_amdgcn_s_barrier()
#define PG_SCHED __builtin_amdgcn_sched_barrier(0)
    typename Sched::Unit cur, nxt; int ui = 0;
    if (!S.next(0, cur)) return;
    f32x4 acc[2][2][4][2];
#pragma unroll
    for (int a = 0; a < 2; ++a)
#pragma unroll
        for (int b = 0; b < 2; ++b)
#pragma unroll
            for (int m = 0; m < 4; ++m)
#pragma unroll
                for (int n = 0; n < 2; ++n) acc[a][b][m][n] = (f32x4){0.f, 0.f, 0.f, 0.f};
    s16x8 At[4][2], B0[2][2], B1[2][2];
    const char* cA; const char* cB; unsigned vA[2][2];
    S.addr(cur, RA, CA, cA, vA, cB);
    bool skip1 = Sched::half1_empty(cur);
    PG_STAGE(PG_SB(0, 0), cB, voffB); PG_STAGE(PG_SA(0, 0), cA, vA[0]); PG_STAGE(PG_SB(0, 1), cB + hstepB, voffB); PG_STAGE(PG_SA(0, 1), cA, vA[1]);
    if (wr == 1) PG_BAR;
    PG_WAIT_V(4); PG_BAR;
    PG_STAGE(PG_SB(1, 0), cB + kstep, voffB); PG_STAGE(PG_SA(1, 0), cA + kstep, vA[0]); PG_STAGE(PG_SB(1, 1), cB + hstepB + kstep, voffB);
    PG_WAIT_V(6); PG_BAR;
    for (;;) {
        const bool has_next = S.next(ui + 1, nxt);
        const char* nA = cA; const char* nB = cB; unsigned vN[2][2] = {{vA[0][0], vA[0][1]}, {vA[1][0], vA[1][1]}};
        if (has_next) S.addr(nxt, RA, CA, nA, vN, nB);
        for (int t = 0; t < nt; t += 2) {
            const bool last = (t == nt - 2);
            const char* a1 = cA + (size_t)(t + 1) * kstep;
            const char* a2 = last ? nA : cA + (size_t)(t + 2) * kstep; const char* b2 = last ? nB : cB + (size_t)(t + 2) * kstep;
            const char* a3 = a2 + kstep; const char* b3 = b2 + kstep;
            unsigned w0[2], w1[2];
            w0[0] = last ? vN[0][0] : vA[0][0]; w0[1] = last ? vN[0][1] : vA[0][1]; w1[0] = last ? vN[1][0] : vA[1][0]; w1[1] = last ? vN[1][1] : vA[1][1];
            PG_LDB(B0, 0, 0); PG_SCHED; PG_LDA(At, 0, 0); PG_STAGE(PG_SA(1, 1), a1, vA[1]);
            PG_WAIT_L(8); PG_BAR; PG_WAIT_L(0); PG_MMA(0, 0, At, B0); PG_BAR; PG_SCHED;
            PG_LDB(B1, 0, 1); PG_STAGE(PG_SB(0, 0), b2, voffB);
            PG_BAR; PG_WAIT_L(0); PG_MMA(0, 1, At, B1); PG_BAR;
            PG_LDA(At, 0, 1); PG_STAGE(PG_SA(0, 0), a2, w0);
            PG_BAR; PG_WAIT_L(0); PG_MMA(1, 0, At, B0); PG_BAR; PG_SCHED;
            PG_STAGE(PG_SB(0, 1), b2 + hstepB, voffB);
            PG_WAIT_V(6); PG_BAR; PG_MMA(1, 1, At, B1); PG_BAR;
            PG_LDB(B0, 1, 0); PG_SCHED; PG_LDA(At, 1, 0); PG_STAGE(PG_SA(0, 1), a2, w1);
            PG_WAIT_L(8); PG_BAR; PG_WAIT_L(0); PG_MMA(0, 0, At, B0); PG_BAR; PG_SCHED;
            PG_LDB(B1, 1, 1); PG_STAGE(PG_SB(1, 0), b3, voffB);
            PG_BAR; PG_WAIT_L(0); PG_MMA(0, 1, At, B1); PG_BAR;
            PG_LDA(At, 1, 1); PG_STAGE(PG_SA(1, 0), a3, w0);
            PG_BAR; PG_WAIT_L(0); PG_MMA(1, 0, At, B0); PG_BAR; PG_SCHED;
            PG_STAGE(PG_SB(1, 1), b3 + hstepB, voffB);
            PG_WAIT_V(6); PG_BAR; PG_MMA(1, 1, At, B1); PG_BAR;
        }
        E(acc, cur, wr, wc, fr, fq);
        if (!has_next) break;
#pragma unroll
        for (int a = 0; a < 2; ++a)
#pragma unroll
            for (int b = 0; b < 2; ++b)
#pragma unroll
                for (int m = 0; m < 4; ++m)
#pragma unroll
                    for (int n = 0; n < 2; ++n) acc[a][b][m][n] = (f32x4){0.f, 0.f, 0.f, 0.f};
        cur = nxt; cA = nA; cB = nB; ++ui; skip1 = Sched::half1_empty(cur);
        vA[0][0] = vN[0][0]; vA[0][1] = vN[0][1]; vA[1][0] = vN[1][0]; vA[1][1] = vN[1][1];
    }
    PG_WAIT_V(0);
    if (wr == 0) PG_BAR;
    PG_BAR;
#undef PG_SA
#undef PG_SB
#undef PG_STAGE
#undef PG_LDA
#undef PG_LDB
#undef PG_MMA
#undef PG_WAIT_V
#undef PG_WAIT_L
#undef PG_BAR
#undef PG_SCHED
}

struct DenseSched {
    struct Unit { int pm, pn; };
    static DI bool half1_empty(const Unit&) { return false; }
    const char* A; const char* Bt; int K, nM, nN, G, c;
    DI bool next(int i, Unit& u) const {
        const int nwg = nM * nN; const long L = (long)i * G + c; if (L >= nwg) return false;
        int wgid = (int)L; { const int q = nwg / 8, r = nwg % 8, xcd = wgid % 8, off = wgid / 8; wgid = (xcd < r ? xcd * (q + 1) : r * (q + 1) + (xcd - r) * q) + off; }
        const int nig = 8 * nN, gid = wgid / nig, fm = gid * 8, gsz = (nM - fm) < 8 ? (nM - fm) : 8;
        u.pm = fm + ((wgid % nig) % gsz); u.pn = (wgid % nig) / gsz; return true;
    }
    DI void addr(const Unit& u, const int (&R)[2], const int (&C)[2], const char*& aBase, unsigned (&vA)[2][2], const char*& bBase) const {
        aBase = A + (size_t)u.pm * 256 * K * 2; bBase = Bt + (size_t)u.pn * 256 * K * 2;
#pragma unroll
        for (int h = 0; h < 2; ++h)
#pragma unroll
            for (int i = 0; i < 2; ++i) vA[h][i] = (unsigned)((h * 128 + R[i]) * K + C[i]) * 2u;
    }
};
}

DI void transpose_block(const float* src, size_t lds_, bool valid, u16* d0, u16* d1, u16* d2, u16* d3) {
    f32x4 v[8];
#pragma unroll
    for (int j = 0; j < 8; ++j) v[j] = valid ? __builtin_nontemporal_load((const f32x4*)(src + (size_t)j * lds_)) : f32x4{0.f, 0.f, 0.f, 0.f};
    __builtin_nontemporal_store(u32x4{pack2(v[0].x, v[1].x), pack2(v[2].x, v[3].x), pack2(v[4].x, v[5].x), pack2(v[6].x, v[7].x)}, (u32x4*)d0);
    __builtin_nontemporal_store(u32x4{pack2(v[0].y, v[1].y), pack2(v[2].y, v[3].y), pack2(v[4].y, v[5].y), pack2(v[6].y, v[7].y)}, (u32x4*)d1);
    __builtin_nontemporal_store(u32x4{pack2(v[0].z, v[1].z), pack2(v[2].z, v[3].z), pack2(v[4].z, v[5].z), pack2(v[6].z, v[7].z)}, (u32x4*)d2);
    __builtin_nontemporal_store(u32x4{pack2(v[0].w, v[1].w), pack2(v[2].w, v[3].w), pack2(v[4].w, v[5].w), pack2(v[6].w, v[7].w)}, (u32x4*)d3);
}

DI void phase_convert(const Params& P) {
    const int tid = threadIdx.x, lane = tid & 63, wid = tid >> 6, kq = lane & 7, ng = lane >> 3;
    if (blockIdx.x == 0 && tid < 64) ((int*)(P.ws + WS_CNT))[tid] = 0;
    {
        u16* hi = (u16*)(P.ws + WS_WRT); u16* lo = hi + 80 * 1024;
        for (int idx = blockIdx.x * 512 + tid; idx < 80 * 1024; idx += gridDim.x * 512) {
            const int n = idx >> 10, k = idx & 1023;
            float w = 0.f;
            if (n < 8) w = P.w_rg[k * 8 + n]; else if (n < 72) w = P.w_re[k * 64 + (n - 8)];
            const u16 hb = f2bf(w);
            hi[idx] = hb; lo[idx] = f2bf(w - bf2f(hb));
        }
    }
    u16* wint = (u16*)(P.ws + WS_WINT); u16* woutt = (u16*)(P.ws + WS_WOUTT);
    const int gw = blockIdx.x * 8 + wid, nw = gridDim.x * 8;
    for (int T = gw; T < 1920 + 512; T += nw) {
        if (T < 1920) {
            const int kb = T / 120, nb = T - kb * 120;
            const int n4 = 32 * nb + 4 * ng;
            int src; bool valid = true;
            if (n4 < 1536) src = n4; else if (n4 < 3584) src = n4 + 16; else if (n4 < 3600) src = 1536 + (n4 - 3584); else if (n4 < 3608) src = n4; else { src = 0; valid = false; }
            u16* d = wint + (size_t)n4 * 1024 + 64 * kb + 8 * kq;
            transpose_block(P.w_in + (size_t)(64 * kb + 8 * kq) * WIN_LD + src, WIN_LD, valid, d, d + 1024, d + 2048, d + 3072);
        } else {
            const int t2 = T - 1920, kb = t2 >> 5, nb = t2 & 31;
            const int n4 = 32 * nb + 4 * ng;
            u16* d = woutt + (size_t)n4 * 1024 + 64 * kb + 8 * kq;
            transpose_block(P.w_out + (size_t)(64 * kb + 8 * kq) * DM + n4, DM, true, d, d + 1024, d + 2048, d + 3072);
        }
    }
    {
        uint2* xb = (uint2*)(P.ws + WS_XB);
        const int gwv = blockIdx.x * 8 + wid, nwv = gridDim.x * 8;
        float4 va[2][4];
#define XC_FETCH(r_) do { _Pragma("unroll") for (int rr = 0; rr < 2; ++rr) _Pragma("unroll") for (int j = 0; j < 4; ++j) va[rr][j] = ldnt4(P.x + (size_t)((r_) + rr) * DM + lane * 4 + 256 * j); } while (0)
        int r = gwv * 2;
        if (r < NTOK) XC_FETCH(r);
        for (; r < NTOK; r += nwv * 2) {
            float4 vc[2][4];
#pragma unroll
            for (int rr = 0; rr < 2; ++rr)
#pragma unroll
                for (int j = 0; j < 4; ++j) vc[rr][j] = va[rr][j];
            if (r + nwv * 2 < NTOK) XC_FETCH(r + nwv * 2);
#pragma unroll
            for (int rr = 0; rr < 2; ++rr)
#pragma unroll
                for (int j = 0; j < 4; ++j) xb[((size_t)(r + rr) * DM + lane * 4 + 256 * j) >> 2] = make_uint2(pack2(vc[rr][j].x, vc[rr][j].y), pack2(vc[rr][j].z, vc[rr][j].w));
        }
#undef XC_FETCH
    }
}

DI void convert_experts(const Params& P, int first_wave, int n_waves) {
    const int tid = threadIdx.x, lane = tid & 63, kq = lane & 7, ng = lane >> 3;
    u16* wgu = (u16*)(P.ws + WS_WGU); u16* wd = (u16*)(P.ws + WS_WD);
    for (int T = first_wave; T < 192 * 256; T += n_waves) {
        const int mat = T >> 8, t2 = T & 255;
        const int e = mat / 3, which = mat - e * 3;
        if (which < 2) {
            const int kb = t2 >> 4, nb = t2 & 15;
            const int n4 = 32 * nb + 4 * ng;
            const float* src = (which ? P.w_up : P.w_gate) + (size_t)e * (1024 * 512) + (size_t)(64 * kb + 8 * kq) * 512 + n4;
            u16* d = wgu + ((size_t)(e * 4 + (n4 >> 7)) * 256 + which * 128 + (n4 & 127)) * 1024 + 64 * kb + 8 * kq;
            transpose_block(src, 512, true, d, d + 1024, d + 2048, d + 3072);
        } else {
            const int kb = t2 >> 5, nb = t2 & 31;
            const int n4 = 32 * nb + 4 * ng;
            const float* src = P.w_down + (size_t)e * (512 * 1024) + (size_t)(64 * kb + 8 * kq) * 1024 + n4;
            u16* d = wd + ((size_t)e * 1024 + n4) * 512 + 64 * kb + 8 * kq;
            transpose_block(src, 1024, true, d, d + 512, d + 1024, d + 1536);
        }
    }
}

struct EpiInproj {
    u16* proj; float* small;
    DI void operator()(const pg::f32x4 (&acc)[2][2][4][2], const pg::DenseSched::Unit& u, int wr, int wc, int fr, int fq) const {
        const int row0 = u.pm * 256 + wr * 64 + fr;
        if (u.pn < 14) {
            const int col0 = u.pn * 256 + wc * 32 + 8 * fq;
#pragma unroll
            for (int ai = 0; ai < 2; ++ai)
#pragma unroll
                for (int m = 0; m < 4; ++m) {
                    u16* rowp = proj + (size_t)(row0 + ai * 128 + m * 16) * PLD + col0;
#pragma unroll
                    for (int bj = 0; bj < 2; ++bj) {
                        const pg::f32x4 v0 = acc[ai][bj][m][0], v1 = acc[ai][bj][m][1];
                        *(uint4*)(rowp + bj * 128) = make_uint4(pack2(v0[0], v0[1]), pack2(v0[2], v0[3]), pack2(v1[0], v1[1]), pack2(v1[2], v1[3]));
                    }
                }
        } else if (wc == 0 && fq < 3) {
#pragma unroll
            for (int ai = 0; ai < 2; ++ai)
#pragma unroll
                for (int m = 0; m < 4; ++m) {
                    float* rowp = small + (size_t)(row0 + ai * 128 + m * 16) * 24 + 8 * fq;
                    const pg::f32x4 v0 = acc[ai][0][m][0], v1 = acc[ai][0][m][1];
                    *(float4*)rowp = make_float4(v0[0], v0[1], v0[2], v0[3]); *(float4*)(rowp + 4) = make_float4(v1[0], v1[1], v1[2], v1[3]);
                }
        }
    }
};
DI void phase_inproj(const Params& P, char* lds) {
    pg::DenseSched S{(const char*)(P.ws + WS_XB), (const char*)(P.ws + WS_WINT), DM, 64, 15, (int)gridDim.x, (int)blockIdx.x};
    EpiInproj E{(u16*)(P.ws + WS_PROJ), (float*)(P.ws + WS_SMALL)};
    pg::gemm_phase(( LAS unsigned char*)lds, S, E, DM);
}

constexpr int PG_RAWQ = 0, PG_RAWK = 33792, PG_AMAT = 0, PG_T = 17408, PG_KN = 67584, PG_QN = 84992, PG_RT = 102400, PG_MISC = 139264;

constexpr int PGL_QE = 26624, PGL_KE = 35840, PGL_TB = 45056, PGL_W = 140288;
struct GlaIn { f32x4 l[4]; u32x4 q[2], k[2]; };
DI void gla_shadow(const Params& P, char* lds, int U, int wq, int lane, const GlaIn& gi);
DI void gla_attn_tiles(const Params& P, char* lds, int U, int wid, int lane);
struct PrepPre { u32x4 xin[11]; float bbv, abv; f32x4 gwv; float gb; };
DI void prep_prefetch(const Params& P, int U, int tid, PrepPre& pre) {
    const int c = U & 31, hd = (U >> 5) & 3, b = U >> 7;
    const int t0 = b * SEQ + c * 64;
    const u16* proj = (const u16*)(P.ws + WS_PROJ);
    const float* small = (const float*)(P.ws + WS_SMALL);
    if (tid < 384) {
        const int cg = tid % 48, pb = tid / 48;
        const int col = C_QB + (cg >> 4) * 512 + hd * 128 + (cg & 15) * 8;
#pragma unroll
        for (int j = 0; j < 11; ++j) {
            const int pos = pb * 8 - 3 + j;
            if (pos >= 0 || c > 0) pre.xin[j] = *(const u32x4*)(proj + (size_t)(t0 + pos) * PLD + col);
            else pre.xin[j] = u32x4{0u, 0u, 0u, 0u};
        }
    }
    if (tid < 64) { pre.bbv = small[(size_t)(t0 + tid) * 24 + 16 + hd]; pre.abv = small[(size_t)(t0 + tid) * 24 + 20 + hd]; }
    if (tid >= 256) {
        const int lt = tid - 256;
        pre.gwv = *(const f32x4*)(P.w_gk_up + (lt >> 4) * 256 + hd * 64 + (lt & 15) * 4);
        if (lt < 64) pre.gb = P.b_gk[hd * 64 + lt];
    }
}
DI void gdn_prep_unit(const Params& P, char* lds, int U, PrepPre& pre, int Unext) {
    int tidv = threadIdx.x;
    asm volatile("" : "+v"(tidv));
    const int tid = tidv, lane = tid & 63, wid = __builtin_amdgcn_readfirstlane(tid >> 6), r = lane & 31, h5 = lane >> 5;
    const int c = U & 31, hd = (U >> 5) & 3, b = U >> 7;
    const int t0 = b * SEQ + c * 64;
    const u16* proj = (const u16*)(P.ws + WS_PROJ);
    const float* small = (const float*)(P.ws + WS_SMALL);
    unsigned char* ub = P.ws + WS_GDN + (size_t)U * GDN_UNIT;
    u16* g_negw = (u16*)ub; u16* g_qd = (u16*)(ub + 16384); u16* g_kdt = (u16*)(ub + 32768); u16* g_attn = (u16*)(ub + 49152); u16* g_uf = (u16*)(ub + 57344);
    float* rawq = (float*)(lds + PG_RAWQ); float* rawk = (float*)(lds + PG_RAWK);
    float* amat = (float*)(lds + PG_AMAT);
    float* sgam = (float*)(lds + PG_MISC); float* sbeta = sgam + 64; float* srq = sgam + 128; float* srk = sgam + 192;

    GlaIn gin;
    if (wid >= 1 && wid <= 4) {
        const int tg = t0 + lane, dg = 16 * (wid - 1);
#pragma unroll
        for (int q = 0; q < 4; ++q) gin.l[q] = *(const f32x4*)(small + (size_t)tg * 24 + 4 * q);
        gin.q[0] = *(const u32x4*)(proj + (size_t)tg * PLD + C_QA + hd * 64 + dg); gin.q[1] = *(const u32x4*)(proj + (size_t)tg * PLD + C_QA + hd * 64 + dg + 8);
        gin.k[0] = *(const u32x4*)(proj + (size_t)tg * PLD + C_KA + hd * 64 + dg); gin.k[1] = *(const u32x4*)(proj + (size_t)tg * PLD + C_KA + hd * 64 + dg + 8);
    }
    if (wid >= 4) {
        const int lt = tid - 256;
        float* gw = (float*)(lds + PGL_W);
        *(f32x4*)(gw + lt * 4) = pre.gwv;
        if (lt < 64) gw[1024 + lt] = pre.gb;
    }
    if (wid == 0) {
        const float bbv = pre.bbv, abv = pre.abv;
        const float z = abv + P.dt_bias[hd];
        const float sp = z > 20.f ? z : (z < -15.f ? __expf(z) : __logf(1.f + __expf(z)));
        float g = -__expf(P.a_log[hd]) * sp;
        g = wave_scan_incl(g);
        sgam[lane] = g; sbeta[lane] = 1.f / (1.f + __expf(-bbv));
    }
    __syncthreads();
    if (tid < 384) {
        const int cg = tid % 48, pb = tid / 48;
        const int which = cg >> 4, d0 = (cg & 15) * 8;
        const int col = C_QB + which * 512 + hd * 128 + d0;
        const int cch = which * 512 + hd * 128 + d0;
        float w[4][8];
#pragma unroll
        for (int i = 0; i < 4; ++i) {
            const float4 a = *(const float4*)(P.conv_w + i * 1536 + cch), b2 = *(const float4*)(P.conv_w + i * 1536 + cch + 4);
            w[i][0] = a.x; w[i][1] = a.y; w[i][2] = a.z; w[i][3] = a.w; w[i][4] = b2.x; w[i][5] = b2.y; w[i][6] = b2.z; w[i][7] = b2.w;
        }
        float sv[8][8];
#pragma unroll
        for (int p = 0; p < 8; ++p) {
#pragma unroll
            for (int ch2 = 0; ch2 < 4; ++ch2) {
                float y0 = 0.f, y1 = 0.f;
#pragma unroll
                for (int i = 0; i < 4; ++i) {
                    const u32x4 xr = pre.xin[p + i];
                    const unsigned xw = ch2 == 0 ? xr.x : (ch2 == 1 ? xr.y : (ch2 == 2 ? xr.z : xr.w));
                    y0 += w[i][2 * ch2] * bflo(xw); y1 += w[i][2 * ch2 + 1] * bfhi(xw);
                }
                sv[p][2 * ch2] = silu_f(y0); sv[p][2 * ch2 + 1] = silu_f(y1);
            }
        }
        if (which < 2) {
            float* dst = (which ? rawk : rawq) + (pb * 8) * 132 + d0;
#pragma unroll
            for (int p = 0; p < 8; ++p) {
                *(float4*)(dst + p * 132) = make_float4(sv[p][0], sv[p][1], sv[p][2], sv[p][3]);
                *(float4*)(dst + p * 132 + 4) = make_float4(sv[p][4], sv[p][5], sv[p][6], sv[p][7]);
            }
        } else {
            float bt[8];
#pragma unroll
            for (int p = 0; p < 8; ++p) bt[p] = sbeta[pb * 8 + p];
#pragma unroll
            for (int ch = 0; ch < 8; ++ch)
                *(uint4*)(lds + PG_RT + (d0 + ch) * 144 + pb * 16) =
                    make_uint4(pack2(bt[0] * sv[0][ch], bt[1] * sv[1][ch]), pack2(bt[2] * sv[2][ch], bt[3] * sv[3][ch]), pack2(bt[4] * sv[4][ch], bt[5] * sv[5][ch]), pack2(bt[6] * sv[6][ch], bt[7] * sv[7][ch]));
        }
    }
    __syncthreads();
    if (tid < 128) {
        const int pos = tid & 63, which = tid >> 6;
        const float* src = (which ? rawk : rawq) + pos * 132;
        float ss = 0.f;
#pragma unroll 8
        for (int d = 0; d < 128; d += 4) { const float4 v = *(const float4*)(src + d); ss += v.x * v.x + v.y * v.y + v.z * v.z + v.w * v.w; }
        const float rn = rsqrtf(ss + 1e-6f);
        if (which) srk[pos] = rn; else srq[pos] = rn * 0.08838834764831845f;
    }
    __syncthreads();
    {
        const int d = tid & 127, pq = tid >> 7;
        const float glast = sgam[63];
        unsigned kd[8], rt[8];
#pragma unroll
        for (int j2 = 0; j2 < 8; ++j2) {
            float kdv[2], rtv[2];
#pragma unroll
            for (int e = 0; e < 2; ++e) {
                const int pos = pq * 16 + j2 * 2 + e;
                const float gm = sgam[pos];
                const float eg = __expf(gm), ek = __expf(glast - gm);
                const float kn = rawk[pos * 132 + d] * srk[pos];
                const float qn = rawq[pos * 132 + d] * srq[pos];
                *(u16*)(lds + PG_KN + pos * 272 + d * 2) = f2bf(kn);
                *(u16*)(lds + PG_QN + pos * 272 + d * 2) = f2bf(qn);
                g_qd[pos * 128 + d] = f2bf(qn * eg);
                kdv[e] = kn * ek; rtv[e] = sbeta[pos] * kn * eg;
            }
            kd[j2] = pack2(kdv[0], kdv[1]); rt[j2] = pack2(rtv[0], rtv[1]);
        }
        uint4* kp = (uint4*)(g_kdt + d * 64 + pq * 16);
        kp[0] = make_uint4(kd[0], kd[1], kd[2], kd[3]); kp[1] = make_uint4(kd[4], kd[5], kd[6], kd[7]);
        uint4* rp = (uint4*)(lds + PG_RT + (128 + d) * 144 + pq * 32);
        rp[0] = make_uint4(rt[0], rt[1], rt[2], rt[3]); rp[1] = make_uint4(rt[4], rt[5], rt[6], rt[7]);
        if (tid == 0) ((float*)(P.ws + WS_DL))[U] = __expf(glast);
    }
    __syncthreads();
    {
        const int which = wid >> 2, ti = (wid >> 1) & 1, tj = wid & 1;
        f32x16 acc;
#pragma unroll
        for (int i = 0; i < 16; ++i) acc[i] = 0.f;
        if (!(ti == 0 && tj == 1)) {
            const char* xa = lds + (which ? PG_QN : PG_KN) + (32 * ti + r) * 272 + h5 * 16;
            const char* xb = lds + PG_KN + (32 * tj + r) * 272 + h5 * 16;
#pragma unroll
            for (int ks = 0; ks < 8; ++ks) acc = mfma32(ld_frag(xa + ks * 32), ld_frag(xb + ks * 32), acc);
        }
        const int j = 32 * tj + r;
        const float gj = sgam[j];
#pragma unroll
        for (int i = 0; i < 16; ++i) {
            const int ii = 32 * ti + crow(i, h5);
            const float dec = __expf(fminf(sgam[ii] - gj, 0.f));
            if (which == 0) amat[ii * 68 + j] = (j < ii) ? sbeta[ii] * acc[i] * dec : 0.f;
            else g_attn[ii * 64 + j] = f2bf((j <= ii) ? acc[i] * dec : 0.f);
        }
    }
    __syncthreads();
    if (Unext >= 0 && wid != 0) prep_prefetch(P, Unext, tid, pre);
    if (wid == 0) {
        const int hb = lane >> 5, cb = lane & 31;
        const float* ab = amat + (32 * hb) * 68 + 32 * hb;
        float* tbs = (float*)(lds + PGL_TB) + hb * (32 * 33);
        float t[32];
        float4 an[8], ac[8];
        float dn = 0.f, dc;
#define INV_LOAD(i, dst) do { _Pragma("unroll") for (int q = 0; q < 8; ++q) if (q < ((i) + 3) / 4) dst[q] = *(const float4*)(ab + abo + (i) * 68 + 4 * q); } while (0)
        dc = ab[cb];
#pragma unroll
        for (int q = 0; q < 8; ++q) { ac[q] = make_float4(0.f, 0.f, 0.f, 0.f); an[q] = make_float4(0.f, 0.f, 0.f, 0.f); }
        int abo = 0;
#pragma unroll
        for (int i = 0; i < 32; ++i) {
            { const float tp = (i > 0) ? t[i > 0 ? i - 1 : 0] : dc; asm volatile("" : "+v"(abo) : "v"(tp)); }
            if (i + 1 < 32) { dn = (ab + abo)[(i + 1) * 68 + cb]; INV_LOAD(i + 1, an); }
            __builtin_amdgcn_sched_barrier(0);
            float s0 = -dc, s1 = 0.f;
#pragma unroll
            for (int q = 0; q < 8; ++q) { const int j = 4 * q;
                if (j + 0 < i) s0 -= ac[q].x * t[j + 0]; if (j + 1 < i) s1 -= ac[q].y * t[j + 1];
                if (j + 2 < i) s0 -= ac[q].z * t[j + 2]; if (j + 3 < i) s1 -= ac[q].w * t[j + 3]; }
            t[i] = s0 + s1; dc = dn;
            __builtin_amdgcn_sched_barrier(0);
#pragma unroll
            for (int q = 0; q < 8; ++q) ac[q] = an[q];
        }
#undef INV_LOAD
#pragma unroll
        for (int i = 0; i < 32; ++i) {
            *(u16*)(lds + PG_T + (32 * hb + i) * 144 + (32 * hb + cb) * 2) = f2bf(t[i]);
            tbs[i * 33 + cb] = t[i];
            if (hb) *(u16*)(lds + PG_T + i * 144 + (32 + cb) * 2) = (u16)0;
        }
        *(u16*)(lds + PG_T + lane * 144 + lane * 2) = (u16)0x3F80;
        tbs[cb * 33 + cb] = 1.f;
        const float* t11 = (const float*)(lds + PGL_TB); const float* t22 = t11 + 32 * 33;
        f32x16 ax, at;
#pragma unroll
        for (int i = 0; i < 16; ++i) { ax[i] = 0.f; at[i] = 0.f; }
        static_for<16>([&](auto skc) {
            constexpr int sk = decltype(skc)::value;
            ax = __builtin_amdgcn_mfma_f32_32x32x2f32(amat[(32 + cb) * 68 + 2 * sk + hb], t11[(2 * sk + hb) * 33 + cb], ax, 0, 0, 0);
        });
        static_for<16>([&](auto skc) {
            constexpr int sk = decltype(skc)::value;
            constexpr int r0 = (sk & 3) + 8 * (sk >> 2);
            at = __builtin_amdgcn_mfma_f32_32x32x2f32(t22[cb * 33 + r0 + 4 * hb], ax[sk], at, 0, 0, 0);
        });
#pragma unroll
        for (int i = 0; i < 16; ++i) *(u16*)(lds + PG_T + (32 + crow(i, hb)) * 144 + cb * 2) = f2bf(-at[i]);
        if (Unext >= 0) prep_prefetch(P, Unext, tid, pre);
    } else if (wid <= 4) {
        gla_shadow(P, lds, U, wid - 1, lane, gin);
    }
    __syncthreads();
    if (wid < 4) gla_attn_tiles(P, lds, U, wid, lane);
    {
        f32x16 acc[2];
#pragma unroll
        for (int m = 0; m < 2; ++m)
#pragma unroll
            for (int i = 0; i < 16; ++i) acc[m][i] = 0.f;
        const char* tb = lds + PG_T + r * 144 + h5 * 16;
        const char* rb = lds + PG_RT + (32 * wid + r) * 144 + h5 * 16;
#pragma unroll
        for (int ks = 0; ks < 4; ++ks) {
            const bf16x8 bfr = ld_frag(rb + ks * 32);
#pragma unroll
            for (int m = 0; m < 2; ++m) acc[m] = mfma32(ld_frag(tb + m * 32 * 144 + ks * 32), bfr, acc[m]);
        }
        if (wid < 4) {
#pragma unroll
            for (int m = 0; m < 2; ++m) {
                uint4* up = (uint4*)(g_uf + ((size_t)(wid * 2 + m) * 64 + lane) * 16);
                up[0] = make_uint4(pack2(acc[m][0], acc[m][1]), pack2(acc[m][2], acc[m][3]), pack2(acc[m][4], acc[m][5]), pack2(acc[m][6], acc[m][7]));
                up[1] = make_uint4(pack2(acc[m][8], acc[m][9]), pack2(acc[m][10], acc[m][11]), pack2(acc[m][12], acc[m][13]), pack2(acc[m][14], acc[m][15]));
            }
        } else {
#pragma unroll
            for (int m = 0; m < 2; ++m)
#pragma unroll
                for (int i = 0; i < 16; ++i) g_negw[(32 * m + crow(i, h5)) * 128 + 32 * (wid - 4) + r] = f2bf(-acc[m][i]);
        }
    }
    __syncthreads();
}

DI void gla_shadow(const Params& P, char* lds, int U, int wq, int lane, const GlaIn& gi) {
    unsigned char* ub = P.ws + WS_GLA + (size_t)U * GLA_UNIT;
    u16* g_qe = (u16*)ub; u16* g_kdt = (u16*)(ub + 16384); float* g_dec = (float*)(ub + 24576);
    const float* gw = (const float*)(lds + PGL_W);
    const int d0 = 16 * wq;
    const float lr[16] = {gi.l[0].x, gi.l[0].y, gi.l[0].z, gi.l[0].w, gi.l[1].x, gi.l[1].y, gi.l[1].z, gi.l[1].w, gi.l[2].x, gi.l[2].y, gi.l[2].z, gi.l[2].w, gi.l[3].x, gi.l[3].y, gi.l[3].z, gi.l[3].w};
    const unsigned qw[8] = {gi.q[0].x, gi.q[0].y, gi.q[0].z, gi.q[0].w, gi.q[1].x, gi.q[1].y, gi.q[1].z, gi.q[1].w}, kw[8] = {gi.k[0].x, gi.k[0].y, gi.k[0].z, gi.k[0].w, gi.k[1].x, gi.k[1].y, gi.k[1].z, gi.k[1].w};
    unsigned qe[8], ke[8];
#pragma unroll
    for (int g4 = 0; g4 < 4; ++g4) {
        const float4 bz = *(const float4*)(gw + 1024 + d0 + 4 * g4);
        float z[4] = {bz.x, bz.y, bz.z, bz.w};
#pragma unroll
        for (int r = 0; r < 16; ++r) {
            const float4 wv = *(const float4*)(gw + r * 64 + d0 + 4 * g4);
            z[0] += lr[r] * wv.x; z[1] += lr[r] * wv.y; z[2] += lr[r] * wv.z; z[3] += lr[r] * wv.w;
        }
        float bb[4], blast[4];
#pragma unroll
        for (int e = 0; e < 4; ++e) bb[e] = (fminf(z[e], 0.f) - __logf(1.f + __expf(-fabsf(z[e])))) * 0.0625f;
#pragma unroll
        for (int e = 0; e < 4; ++e) bb[e] = wave_scan_incl(bb[e]);
#pragma unroll
        for (int e = 0; e < 4; ++e) blast[e] = __builtin_bit_cast(float, __builtin_amdgcn_readlane(__builtin_bit_cast(int, bb[e]), 63));
        float qev[4], kev[4];
#pragma unroll
        for (int e = 0; e < 4; ++e) {
            const int j = 4 * g4 + e, d = d0 + j;
            const float q = ((j & 1) ? bfhi(qw[j >> 1]) : bflo(qw[j >> 1])) * 0.125f, k = (j & 1) ? bfhi(kw[j >> 1]) : bflo(kw[j >> 1]);
            qev[e] = q * __expf(bb[e]); kev[e] = k * __expf(-bb[e]);
            g_kdt[d * 64 + lane] = f2bf(k * __expf(blast[e] - bb[e]));
            if (lane == 0) g_dec[d] = __expf(blast[e]);
        }
        qe[2 * g4] = pack2(qev[0], qev[1]); qe[2 * g4 + 1] = pack2(qev[2], qev[3]);
        ke[2 * g4] = pack2(kev[0], kev[1]); ke[2 * g4 + 1] = pack2(kev[2], kev[3]);
    }
    const uint4 qa = make_uint4(qe[0], qe[1], qe[2], qe[3]), qb = make_uint4(qe[4], qe[5], qe[6], qe[7]);
    *(uint4*)(lds + PGL_QE + lane * 144 + d0 * 2) = qa; *(uint4*)(lds + PGL_QE + lane * 144 + d0 * 2 + 16) = qb;
    *(uint4*)(lds + PGL_KE + lane * 144 + d0 * 2) = make_uint4(ke[0], ke[1], ke[2], ke[3]); *(uint4*)(lds + PGL_KE + lane * 144 + d0 * 2 + 16) = make_uint4(ke[4], ke[5], ke[6], ke[7]);
    *(uint4*)(g_qe + lane * 64 + d0) = qa; *(uint4*)(g_qe + lane * 64 + d0 + 8) = qb;
}
DI void gla_attn_tiles(const Params& P, char* lds, int U, int wid, int lane) {
    const int r = lane & 31, h5 = lane >> 5;
    u16* g_attn = (u16*)(P.ws + WS_GLA + (size_t)U * GLA_UNIT + 8192);
    const int ti = wid >> 1, tj = wid & 1;
    f32x16 acc;
#pragma unroll
    for (int i = 0; i < 16; ++i) acc[i] = 0.f;
    if (!(ti == 0 && tj == 1)) {
        const char* xa = lds + PGL_QE + (32 * ti + r) * 144 + h5 * 16;
        const char* xb = lds + PGL_KE + (32 * tj + r) * 144 + h5 * 16;
#pragma unroll
        for (int ks = 0; ks < 4; ++ks) acc = mfma32(ld_frag(xa + ks * 32), ld_frag(xb + ks * 32), acc);
    }
    const int j = 32 * tj + r;
#pragma unroll
    for (int i = 0; i < 16; ++i) {
        const int ii = 32 * ti + crow(i, h5);
        g_attn[ii * 64 + j] = f2bf((j <= ii) ? acc[i] : 0.f);
    }
}

DI void phase_prep(const Params& P, char* lds) {
    PrepPre pre;
    if ((int)blockIdx.x < 1024) prep_prefetch(P, blockIdx.x, threadIdx.x, pre);
    for (int u = blockIdx.x; u < 1024; u += gridDim.x) {
        const int un = u + (int)gridDim.x;
        gdn_prep_unit(P, lds, u, pre, un < 1024 ? un : -1);
    }
}

template <bool GDN> struct ScanCfg;
template <> struct ScanCfg<true>  { static constexpr int DK = 128, LDA = 264, NEGW = 0, QD = 16896, KDT = 33792, ATT = 51200, DEC = 0, STAGE = 59904; };
template <> struct ScanCfg<false> { static constexpr int DK = 64,  LDA = 136, NEGW = 0, QD = 0,     KDT = 8704,  ATT = 17408, DEC = 26112, STAGE = 26368; };
constexpr int SC_OST = 2 * 59904, SC_OSTB = 16896;

template <bool GDN>
DI void scan_stream(const Params& P, char* lds, int bh) {
    using C = ScanCfg<GDN>;
    constexpr int DK = C::DK, KT = DK / 32, KS = DK / 16;
    const int tid = threadIdx.x, lane = tid & 63, wid = tid >> 6, r = lane & 31, h5 = lane >> 5;
    const int hd = bh & 3, b = bh >> 2;
    const u16* proj = (const u16*)(P.ws + WS_PROJ);
    u16* mixed = (u16*)(P.ws + WS_MIXED);
    const int U0 = bh * 32;

    if (wid >= 4) {
        const int lt = tid - 256;
        const int epos = lt >> 2, eq = lt & 3;
        float* sgain = (float*)(lds + 153600);
        if (lt < 128) sgain[lt] = (GDN ? P.gdn_g : P.gla_g)[lt];
        const int gcol = (GDN ? C_ZB : C_RA) + hd * 128 + eq * 32;
        const int ocol = (GDN ? 512 : 0) + hd * 128 + eq * 32;
        constexpr int NV = GDN ? 14 : 6;
        uint4 sv[NV]; float sdv = 0.f; uint4 gq[4];
        auto load_chunk = [&](int cidx) {
            if (GDN) {
                const unsigned char* ub = P.ws + WS_GDN + (size_t)(U0 + cidx) * GDN_UNIT;
#pragma unroll
                for (int q = 0; q < 4; ++q) sv[q] = ldnt_u4(ub + (size_t)(lt + 256 * q) * 16);
#pragma unroll
                for (int q = 0; q < 4; ++q) sv[4 + q] = ldnt_u4(ub + 16384 + (size_t)(lt + 256 * q) * 16);
#pragma unroll
                for (int q = 0; q < 4; ++q) sv[8 + q] = ldnt_u4(ub + 32768 + (size_t)(lt + 256 * q) * 16);
#pragma unroll
                for (int q = 0; q < 2; ++q) sv[12 + q] = ldnt_u4(ub + 49152 + (size_t)(lt + 256 * q) * 16);
            } else {
                const unsigned char* ub = P.ws + WS_GLA + (size_t)(U0 + cidx) * GLA_UNIT;
#pragma unroll
                for (int q = 0; q < 6; ++q) sv[q] = ldnt_u4(ub + (size_t)(lt + 256 * q) * 16);
                if (lt < 64) sdv = *(const float*)(ub + 24576 + lt * 4);
            }
        };
        int o264 = (lt >> 4) * 264 + (lt & 15) * 16, o136 = (lt >> 3) * 136 + (lt & 7) * 16;
        auto write_chunk = [&](char* st) {
            if (GDN) {
#pragma unroll
                for (int q = 0; q < 4; ++q) { char* d = st + C::NEGW + o264 + q * (16 * 264); *(uint2*)d = make_uint2(sv[q].x, sv[q].y); *(uint2*)(d + 8) = make_uint2(sv[q].z, sv[q].w); }
#pragma unroll
                for (int q = 0; q < 4; ++q) { char* d = st + C::QD + o264 + q * (16 * 264); *(uint2*)d = make_uint2(sv[4 + q].x, sv[4 + q].y); *(uint2*)(d + 8) = make_uint2(sv[4 + q].z, sv[4 + q].w); }
#pragma unroll
                for (int q = 0; q < 4; ++q) { char* d = st + C::KDT + o136 + q * (32 * 136); *(uint2*)d = make_uint2(sv[8 + q].x, sv[8 + q].y); *(uint2*)(d + 8) = make_uint2(sv[8 + q].z, sv[8 + q].w); }
#pragma unroll
                for (int q = 0; q < 2; ++q) { char* d = st + C::ATT + o136 + q * (32 * 136); *(uint2*)d = make_uint2(sv[12 + q].x, sv[12 + q].y); *(uint2*)(d + 8) = make_uint2(sv[12 + q].z, sv[12 + q].w); }
            } else {
#pragma unroll
                for (int q = 0; q < 6; ++q) {
                    const int base = (q >> 1) == 0 ? C::QD : ((q >> 1) == 1 ? C::ATT : C::KDT);
                    char* d = st + base + o136 + (q & 1) * (32 * 136);
                    *(uint2*)d = make_uint2(sv[q].x, sv[q].y); *(uint2*)(d + 8) = make_uint2(sv[q].z, sv[q].w);
                }
                if (lt < 64) *(float*)(st + C::DEC + lt * 4) = sdv;
            }
        };
        auto load_gate = [&](int cidx) {
            const uint4* gp4 = (const uint4*)(proj + (size_t)(b * SEQ + cidx * 64 + epos) * PLD + gcol);
            gq[0] = gp4[0]; gq[1] = gp4[1]; gq[2] = gp4[2]; gq[3] = gp4[3];
        };
        auto epilogue = [&](int cidx) {
            const int t = b * SEQ + cidx * 64 + epos;
            const char* orow = lds + SC_OST + (cidx & 1) * SC_OSTB + epos * 264 + eq * 64;
            unsigned ov[16];
#pragma unroll
            for (int q = 0; q < 8; ++q) { const uint2 x2 = *(const uint2*)(orow + q * 8); ov[2 * q] = x2.x; ov[2 * q + 1] = x2.y; }
            float ss = 0.f;
#pragma unroll
            for (int q = 0; q < 16; ++q) { const float a = bflo(ov[q]), c2 = bfhi(ov[q]); ss += a * a + c2 * c2; }
            ss += __shfl_xor(ss, 1, 64); ss += __shfl_xor(ss, 2, 64);
            const float rstd = rsqrtf(ss * (1.f / 128.f) + 1e-6f);
            const unsigned gv[16] = {gq[0].x, gq[0].y, gq[0].z, gq[0].w, gq[1].x, gq[1].y, gq[1].z, gq[1].w, gq[2].x, gq[2].y, gq[2].z, gq[2].w, gq[3].x, gq[3].y, gq[3].z, gq[3].w};
            unsigned res[16];
#pragma unroll
            for (int q4 = 0; q4 < 8; ++q4) {
                const float4 gn = *(const float4*)(sgain + eq * 32 + q4 * 4);
                const int q = 2 * q4;
                res[q] = pack2(bflo(ov[q]) * rstd * gn.x * silu_f(bflo(gv[q])), bfhi(ov[q]) * rstd * gn.y * silu_f(bfhi(gv[q])));
                res[q + 1] = pack2(bflo(ov[q + 1]) * rstd * gn.z * silu_f(bflo(gv[q + 1])), bfhi(ov[q + 1]) * rstd * gn.w * silu_f(bfhi(gv[q + 1])));
            }
            uint4* op = (uint4*)(mixed + (size_t)t * DM + ocol);
            op[0] = make_uint4(res[0], res[1], res[2], res[3]); op[1] = make_uint4(res[4], res[5], res[6], res[7]);
            op[2] = make_uint4(res[8], res[9], res[10], res[11]); op[3] = make_uint4(res[12], res[13], res[14], res[15]);
        };
        load_chunk(0);
        write_chunk(lds);
        load_chunk(1);
        load_gate(0);
        __syncthreads();
        for (int c = 0; c < NCH; ++c) {
            asm volatile("" : "+v"(o264), "+v"(o136));
            if (c + 1 < NCH) write_chunk(lds + ((c + 1) & 1) * 59904);
            if (c + 2 < NCH) load_chunk(c + 2);
            if (c > 0) { epilogue(c - 1); load_gate(c); }
            __syncthreads();
        }
        epilogue(NCH - 1);
    } else {
        f32x16 S[KT];
        bf16x8 Sb[KS];
#pragma unroll
        for (int k = 0; k < KT; ++k)
#pragma unroll
            for (int i = 0; i < 16; ++i) S[k][i] = 0.f;
#pragma unroll
        for (int k = 0; k < KS; ++k) { u32x4 z = {0u, 0u, 0u, 0u}; Sb[k] = __builtin_bit_cast(bf16x8, z); }
        const float* dlp = (const float*)(P.ws + WS_DL) + U0;
        uint4 un[4];
        u16 vnx[32];
        auto fetch_uv = [&](int cidx) {
            if (GDN) {
                const uint4* up = (const uint4*)(P.ws + WS_GDN + (size_t)(U0 + cidx) * GDN_UNIT + 57344) + ((size_t)(wid * 2) * 64 + lane) * 2;
                un[0] = ldnt_u4(up); un[1] = ldnt_u4(up + 1); un[2] = ldnt_u4(up + 128); un[3] = ldnt_u4(up + 129);
            } else {
                const u16* vp = proj + (size_t)(b * SEQ + cidx * 64) * PLD + C_VA + hd * 128 + 32 * wid + r;
#pragma unroll
                for (int m = 0; m < 2; ++m)
#pragma unroll
                    for (int i = 0; i < 16; ++i) vnx[m * 16 + i] = vp[(size_t)(32 * m + crow(i, h5)) * PLD];
            }
        };
        fetch_uv(0);
        __syncthreads();
        constexpr int NOPS = GDN ? 56 : 24, N1 = GDN ? 32 : 8, N2 = N1 + 8;
        int rA = r * C::LDA + 8 * h5, r136 = r * 136 + 8 * h5;
#define SC_OFF(n) ((n) < N1 ? (GDN ? ((((n) & 1) ? C::QD : C::NEGW) + 32 * (((n) >> 1) & 1) * C::LDA + 32 * ((n) >> 2)) : (C::QD + 32 * ((n) & 1) * C::LDA + 32 * ((n) >> 1))) \
                  : ((n) < N2 ? (C::ATT + 32 * (((n) - N1) & 1) * 136 + 32 * (((n) - N1) >> 1)) : (C::KDT + 32 * (((n) - N2) >> 2) * 136 + 32 * (((n) - N2) & 3))))
#define SC_LDF(n) ld_frag2(st + SC_OFF(n) + ((n) < N1 ? rA : r136))
        for (int c = 0; c < NCH; ++c) {
            asm volatile("" : "+v"(rA), "+v"(r136));
            const char* st = lds + (c & 1) * 59904;
            bf16x8 fq[4];
#pragma unroll
            for (int n = 0; n < 4; ++n) fq[n] = SC_LDF(n);
            f32x16 vn[2];
            if (GDN) {
                const unsigned w0[8] = {un[0].x, un[0].y, un[0].z, un[0].w, un[1].x, un[1].y, un[1].z, un[1].w};
                const unsigned w1[8] = {un[2].x, un[2].y, un[2].z, un[2].w, un[3].x, un[3].y, un[3].z, un[3].w};
#pragma unroll
                for (int q = 0; q < 8; ++q) { vn[0][2 * q] = bflo(w0[q]); vn[0][2 * q + 1] = bfhi(w0[q]); vn[1][2 * q] = bflo(w1[q]); vn[1][2 * q + 1] = bfhi(w1[q]); }
            } else {
#pragma unroll
                for (int m = 0; m < 2; ++m)
#pragma unroll
                    for (int i = 0; i < 16; ++i) vn[m][i] = bf2f(vnx[m * 16 + i]);
            }
            const float dl = GDN ? dlp[c] : 0.f;
            f32x16 o[2];
#pragma unroll
            for (int m = 0; m < 2; ++m)
#pragma unroll
                for (int i = 0; i < 16; ++i) o[m][i] = 0.f;
            bf16x8 vb[4];
            if (!GDN) { vb[0] = pack8<0>(vn[0]); vb[1] = pack8<1>(vn[0]); vb[2] = pack8<0>(vn[1]); vb[3] = pack8<1>(vn[1]); }
            static_for<NOPS>([&](auto nc) {
                constexpr int n = decltype(nc)::value;
                const bf16x8 af = fq[n & 3];
                if constexpr (n + 4 < NOPS) fq[n & 3] = SC_LDF(n + 4);
                if constexpr (n < N1) {
                    if constexpr (GDN) {
                        constexpr int ks = n >> 2, m = (n >> 1) & 1;
                        if constexpr ((n & 1) == 0) vn[m] = mfma32(af, Sb[ks], vn[m]); else o[m] = mfma32(af, Sb[ks], o[m]);
                    } else {
                        constexpr int ks = n >> 1, m = n & 1;
                        o[m] = mfma32(af, Sb[ks], o[m]);
                    }
                } else if constexpr (n < N2) {
                    constexpr int ks = (n - N1) >> 1, m = (n - N1) & 1;
                    o[m] = mfma32(af, vb[ks], o[m]);
                } else {
                    constexpr int kt = (n - N2) >> 2, ks = (n - N2) & 3;
                    S[kt] = mfma32(af, vb[ks], S[kt]);
                }
                __builtin_amdgcn_sched_group_barrier(0x008, 1, 0);
                __builtin_amdgcn_sched_group_barrier(0x100, 2, 0);
                if constexpr (n == N1 - 1) {
                    if constexpr (GDN) { vb[0] = pack8<0>(vn[0]); vb[1] = pack8<1>(vn[0]); vb[2] = pack8<0>(vn[1]); vb[3] = pack8<1>(vn[1]); }
                    if (c + 1 < NCH) fetch_uv(c + 1);
#pragma unroll
                    for (int k = 0; k < KT; ++k) {
                        if constexpr (GDN) {
#pragma unroll
                            for (int i = 0; i < 16; ++i) S[k][i] *= dl;
                        } else {
#pragma unroll
                            for (int q = 0; q < 4; ++q) {
                                const float4 dc = *(const float4*)(st + C::DEC + (32 * k + 8 * q + 4 * h5) * 4);
                                S[k][4 * q] *= dc.x; S[k][4 * q + 1] *= dc.y; S[k][4 * q + 2] *= dc.z; S[k][4 * q + 3] *= dc.w;
                            }
                        }
                    }
                }
            });
#pragma unroll
            for (int k = 0; k < KT; ++k) { Sb[2 * k] = pack8<0>(S[k]); Sb[2 * k + 1] = pack8<1>(S[k]); }
            char* ost = lds + SC_OST + (c & 1) * SC_OSTB;
#pragma unroll
            for (int m = 0; m < 2; ++m)
#pragma unroll
                for (int i = 0; i < 16; ++i) *(u16*)(ost + (32 * m + crow(i, h5)) * 264 + (32 * wid + r) * 2) = f2bf(o[m][i]);
            __syncthreads();
        }
#undef SC_OFF
#undef SC_LDF
    }
}

DI void phase_scan(const Params& P, char* lds) {
    const int wid = threadIdx.x >> 6;
    if (gridDim.x >= 128) {
        if (blockIdx.x < 64) { if (blockIdx.x < 32) scan_stream<true>(P, lds, blockIdx.x); else scan_stream<false>(P, lds, blockIdx.x - 32); }
        else convert_experts(P, (blockIdx.x - 64) * 8 + wid, (gridDim.x - 64) * 8);
    } else {
        for (int s = blockIdx.x; s < 64; s += gridDim.x) {
            if (s < 32) scan_stream<true>(P, lds, s); else scan_stream<false>(P, lds, s - 32);
            __syncthreads();
        }
        convert_experts(P, blockIdx.x * 8 + wid, gridDim.x * 8);
    }
}

struct EpiOutproj {
    u16* hbuf;
    DI void operator()(const pg::f32x4 (&acc)[2][2][4][2], const pg::DenseSched::Unit& u, int wr, int wc, int fr, int fq) const {
        const int row0 = u.pm * 256 + wr * 64 + fr, col0 = u.pn * 256 + wc * 32 + 8 * fq;
#pragma unroll
        for (int ai = 0; ai < 2; ++ai)
#pragma unroll
            for (int m = 0; m < 4; ++m) {
                u16* rowp = hbuf + (size_t)(row0 + ai * 128 + m * 16) * DM + col0;
#pragma unroll
                for (int bj = 0; bj < 2; ++bj) {
                    const pg::f32x4 v0 = acc[ai][bj][m][0], v1 = acc[ai][bj][m][1];
                    *(uint4*)(rowp + bj * 128) = make_uint4(pack2(v0[0], v0[1]), pack2(v0[2], v0[3]), pack2(v1[0], v1[1]), pack2(v1[2], v1[3]));
                }
            }
    }
};
DI void phase_outproj(const Params& P, char* lds) {
    pg::DenseSched S{(const char*)(P.ws + WS_MIXED), (const char*)(P.ws + WS_WOUTT), DM, 64, 4, (int)gridDim.x, (int)blockIdx.x};
    EpiOutproj E{(u16*)(P.ws + WS_HBUF)};
    pg::gemm_phase((LAS unsigned char*)lds, S, E, DM);
}

DI void phase_ln1_router(const Params& P, char* lds) {
    int tidv = threadIdx.x;
    asm volatile("" : "+v"(tidv));
    const int tid = tidv, lane = tid & 63, wid = __builtin_amdgcn_readfirstlane(tid >> 6);
    const u16* hbuf = (const u16*)(P.ws + WS_HBUF);
    float* x1f = (float*)(P.ws + WS_X1F);
    u16* x1b = (u16*)(P.ws + WS_X1B);
    const u16* wr_hi = (const u16*)(P.ws + WS_WRT); const u16* wr_lo = wr_hi + 80 * 1024;
    int* cnt = (int*)(P.ws + WS_CNT);
    int* ltok = (int*)(P.ws + WS_LTOK);
    float* lgate = (float*)(P.ws + WS_LGATE);
    float* part = (float*)lds;
    float* lg = (float*)(lds + 81920);
    int* rE1 = (int*)(lds + 102400); int* rE2 = rE1 + 64; int* rR1 = rE1 + 128; int* rR2 = rE1 + 192; int* hist = rE1 + 256; int* rbase = rE1 + 320;
    float* rG1 = (float*)(rE1 + 384); float* rG2 = rG1 + 64;
    for (int g = blockIdx.x; g < NTOK / 64; g += gridDim.x) {
        const int row0 = g * 64;
        if (tid < 64) hist[tid] = 0;
        uint2 hv[2][4]; float4 xv[2][4];
#define LN_FETCH(r_) do { _Pragma("unroll") for (int rr = 0; rr < 2; ++rr) { const size_t rb_ = (size_t)((r_) + rr) * DM + lane * 4; \
        _Pragma("unroll") for (int j = 0; j < 4; ++j) { { const u32x2_t hh = __builtin_nontemporal_load((const u32x2_t*)(hbuf + rb_ + 256 * j)); hv[rr][j] = make_uint2(hh.x, hh.y); } xv[rr][j] = ldnt4(P.x + rb_ + 256 * j); } } } while (0)
        LN_FETCH(row0 + wid * 8);
#pragma unroll 1
        for (int it = 0; it < 4; ++it) {
            float4 v[2][4];
#pragma unroll
            for (int rr = 0; rr < 2; ++rr)
#pragma unroll
                for (int j = 0; j < 4; ++j) v[rr][j] = make_float4(ALPHA * xv[rr][j].x + bflo(hv[rr][j].x), ALPHA * xv[rr][j].y + bfhi(hv[rr][j].x), ALPHA * xv[rr][j].z + bflo(hv[rr][j].y), ALPHA * xv[rr][j].w + bfhi(hv[rr][j].y));
            if (it < 3) LN_FETCH(row0 + wid * 8 + 2 * (it + 1));
#pragma unroll
            for (int rr = 0; rr < 2; ++rr) {
                const size_t rbase_ = (size_t)(row0 + wid * 8 + 2 * it + rr) * DM;
                float s = 0.f;
#pragma unroll
                for (int j = 0; j < 4; ++j) s += v[rr][j].x + v[rr][j].y + v[rr][j].z + v[rr][j].w;
                const float mu = wave_sum(s) * (1.f / 1024.f);
                float q = 0.f;
#pragma unroll
                for (int j = 0; j < 4; ++j) { const float a = v[rr][j].x - mu, b2 = v[rr][j].y - mu, c2 = v[rr][j].z - mu, d2 = v[rr][j].w - mu; q += a * a + b2 * b2 + c2 * c2 + d2 * d2; }
                const float rstd = rsqrtf(wave_sum(q) * (1.f / 1024.f) + 1e-5f);
#pragma unroll
                for (int j = 0; j < 4; ++j) {
                    const int col = lane * 4 + 256 * j;
                    const float4 gg = *(const float4*)(P.ln1_g + col), bb = *(const float4*)(P.ln1_b + col);
                    float4 o;
                    o.x = (v[rr][j].x - mu) * rstd * gg.x + bb.x; o.y = (v[rr][j].y - mu) * rstd * gg.y + bb.y;
                    o.z = (v[rr][j].z - mu) * rstd * gg.z + bb.z; o.w = (v[rr][j].w - mu) * rstd * gg.w + bb.w;
                    *(float4*)(x1f + rbase_ + col) = o;
                    *(uint2*)(x1b + rbase_ + col) = make_uint2(pack2(o.x, o.y), pack2(o.z, o.w));
                }
            }
        }
#undef LN_FETCH
        asm volatile("s_waitcnt vmcnt(0)" ::: "memory");
        __syncthreads();
        {
            f32x4 acc[2][5];
#pragma unroll
            for (int mt = 0; mt < 2; ++mt)
#pragma unroll
                for (int n = 0; n < 5; ++n) acc[mt][n] = f32x4{0.f, 0.f, 0.f, 0.f};
            const int mh = wid & 1, kq = wid >> 1, m = lane & 15, kg = lane >> 4;
            const float* ap = x1f + (size_t)(row0 + 32 * mh + m) * DM + 256 * kq + 8 * kg;
            const u16* bhp = wr_hi + (size_t)m * 1024 + 256 * kq + 8 * kg; const u16* blp = wr_lo + (size_t)m * 1024 + 256 * kq + 8 * kg;
#pragma unroll 2
            for (int ks = 0; ks < 8; ++ks) {
                bf16x8 bh[5], bl[5];
#pragma unroll
                for (int n = 0; n < 5; ++n) { bh[n] = ld_frag((const char*)(bhp + n * 16384 + 32 * ks)); bl[n] = ld_frag((const char*)(blp + n * 16384 + 32 * ks)); }
#pragma unroll
                for (int mt = 0; mt < 2; ++mt) {
                    const float4 f0 = *(const float4*)(ap + (size_t)mt * 16 * DM + 32 * ks), f1 = *(const float4*)(ap + (size_t)mt * 16 * DM + 32 * ks + 4);
                    const float f[8] = {f0.x, f0.y, f0.z, f0.w, f1.x, f1.y, f1.z, f1.w};
                    unsigned hi[4], lo[4];
#pragma unroll
                    for (int q = 0; q < 4; ++q) { hi[q] = pack2(f[2 * q], f[2 * q + 1]); lo[q] = pack2(f[2 * q] - bflo(hi[q]), f[2 * q + 1] - bfhi(hi[q])); }
                    const u32x4 hv4 = {hi[0], hi[1], hi[2], hi[3]}, lv4 = {lo[0], lo[1], lo[2], lo[3]};
                    const bf16x8 ah = __builtin_bit_cast(bf16x8, hv4), alo = __builtin_bit_cast(bf16x8, lv4);
#pragma unroll
                    for (int n = 0; n < 5; ++n) { acc[mt][n] = mfma16(ah, bh[n], acc[mt][n]); acc[mt][n] = mfma16(ah, bl[n], acc[mt][n]); acc[mt][n] = mfma16(alo, bh[n], acc[mt][n]); }
                }
            }
#pragma unroll
            for (int mt = 0; mt < 2; ++mt)
#pragma unroll
                for (int n = 0; n < 5; ++n)
#pragma unroll
                    for (int i = 0; i < 4; ++i) part[(kq * 64 + 32 * mh + 16 * mt + 4 * kg + i) * 80 + n * 16 + m] = acc[mt][n][i];
        }
        __syncthreads();
        for (int idx = tid; idx < 64 * 80; idx += 512) {
            const int cc = idx % 80;
            float s = part[idx] + part[5120 + idx] + part[10240 + idx] + part[15360 + idx];
            if (cc < 8) s += P.b_rg[cc]; else if (cc < 72) s += P.b_re[cc - 8];
            lg[idx] = s;
        }
        __syncthreads();
        if (tid < 64) {
            const float* L = lg + tid * 80;
            float mx = L[0]; int gs = 0;
#pragma unroll
            for (int q = 1; q < 8; ++q) { const float v = L[q]; if (v > mx) { mx = v; gs = q; } }
            float den = 0.f;
#pragma unroll
            for (int q = 0; q < 8; ++q) den += __expf(L[q] - mx);
            const float pgroup = 1.f / den;
            const float* E = L + 8 + gs * 8;
            float l1 = E[0]; int e1 = 0;
#pragma unroll
            for (int j = 1; j < 8; ++j) { const float v = E[j]; if (v > l1) { l1 = v; e1 = j; } }
            float l2 = -3.0e38f; int e2 = 0;
#pragma unroll
            for (int j = 0; j < 8; ++j) { const float v = E[j]; if (j != e1 && v > l2) { l2 = v; e2 = j; } }
            const float ex = __expf(l2 - l1);
            const float w1 = 1.f / (1.f + ex), w2 = ex / (1.f + ex);
            const int E1 = gs * 8 + e1, E2 = gs * 8 + e2;
            rE1[tid] = E1; rE2[tid] = E2; rG1[tid] = pgroup * w1; rG2[tid] = pgroup * w2;
            rR1[tid] = atomicAdd(&hist[E1], 1); rR2[tid] = atomicAdd(&hist[E2], 1);
        }
        __syncthreads();
        if (tid < 64) { const int h = hist[tid]; rbase[tid] = h > 0 ? atomicAdd(&cnt[tid], h) : 0; }
        __syncthreads();
        if (tid < 64) {
            const int E1 = rE1[tid], E2 = rE2[tid];
            const int p1 = rbase[E1] + rR1[tid], p2 = rbase[E2] + rR2[tid];
            ltok[E1 * 16384 + p1] = (row0 + tid) * 2; lgate[E1 * 16384 + p1] = rG1[tid];
            ltok[E2 * 16384 + p2] = (row0 + tid) * 2 + 1; lgate[E2 * 16384 + p2] = rG2[tid];
        }
        __syncthreads();
    }
}

constexpr int MOE_TAB = 131072, MOE_LIST = 131072 + 1024, MOE_ROWS = 131072 + 4096, MOE_GATE = MOE_ROWS + 8192;
DI int moe_build_table(const Params& P, char* lds) {
    int* tab = (int*)(lds + MOE_TAB); u16* plist = (u16*)(lds + MOE_LIST);
    const int* cnt = (const int*)(P.ws + WS_CNT);
    const int x = blockIdx.x & 7;
    if (threadIdx.x < 64) {
        const int e = threadIdx.x, c = cnt[e], nrb = (c + 255) >> 8;
        const bool mine = (e & 7) == x;
        const int tail = (mine && nrb > 0 && (c - (nrb - 1) * 256) <= 128) ? 1 : 0, full = mine ? nrb - tail : 0;
        const int ho_incl = (int)wave_scan_incl((float)(nrb * 256)), fu_incl = (int)wave_scan_incl((float)full), ta_incl = (int)wave_scan_incl((float)tail);
        const int nfull = __builtin_amdgcn_readlane(fu_incl, 63), ntail = __builtin_amdgcn_readlane(ta_incl, 63);
        tab[e] = c; tab[64 + e] = ho_incl - nrb * 256;
        const int p = fu_incl - full;
        for (int rb = 0; rb < full; ++rb) plist[p + rb] = (u16)((e << 8) | rb);
        if (tail) plist[nfull + ta_incl - 1] = (u16)((e << 8) | (nrb - 1));
        if (e == 0) tab[129] = nfull + ntail;
    }
    __syncthreads();
    return tab[129] * 4;
}
struct MoeSched {
    struct Unit { int e, rb, ns, slot, nvalid, hrow0; };
    static DI bool half1_empty(const Unit& u) { return u.nvalid <= 128; }
    const int* tab; const u16* plist; const int* rows;
    const char* A; const char* Bt; int nunits, G8, c8, base; bool down;
    DI bool next(int i, Unit& u) const {
        if (i >= 8) return false;
        const int L = (base + i) * G8 + c8; if (L >= nunits) return false;
        const int pr = plist[L >> 2];
        u.e = pr >> 8; u.rb = pr & 255; u.ns = L & 3; u.slot = i;
        u.nvalid = min(256, tab[u.e] - u.rb * 256); u.hrow0 = tab[64 + u.e] + u.rb * 256;
        return true;
    }
    DI void addr(const Unit& u, const int (&R)[2], const int (&C)[2], const char*& aBase, unsigned (&vA)[2][2], const char*& bBase) const {
        if (!down) {
            aBase = A; bBase = Bt + (size_t)(u.e * 4 + u.ns) * 256 * 1024 * 2;
#pragma unroll
            for (int h = 0; h < 2; ++h)
#pragma unroll
                for (int i = 0; i < 2; ++i) vA[h][i] = (unsigned)(rows[u.slot * 256 + h * 128 + R[i]] * 1024 + C[i]) * 2u;
        } else {
            aBase = A + (size_t)u.hrow0 * 512 * 2; bBase = Bt + ((size_t)u.e * 1024 + u.ns * 256) * 512 * 2;
#pragma unroll
            for (int h = 0; h < 2; ++h)
#pragma unroll
                for (int i = 0; i < 2; ++i) vA[h][i] = (unsigned)((h * 128 + R[i]) * 512 + C[i]) * 2u;
        }
    }
};
struct EpiMoeUp {
    u16* H;
    DI void operator()(const pg::f32x4 (&acc)[2][2][4][2], const MoeSched::Unit& u, int wr, int wc, int fr, int fq) const {
        const int col0 = u.ns * 128 + wc * 32 + 8 * fq;
#pragma unroll
        for (int ai = 0; ai < 2; ++ai)
#pragma unroll
            for (int m = 0; m < 4; ++m) {
                const int rl = ai * 128 + wr * 64 + m * 16 + fr;
                if (rl < u.nvalid) {
                    const pg::f32x4 g0 = acc[ai][0][m][0], g1 = acc[ai][0][m][1], u0 = acc[ai][1][m][0], u1 = acc[ai][1][m][1];
                    *(uint4*)(H + (size_t)(u.hrow0 + rl) * 512 + col0) =
                        make_uint4(pack2(silu_f(g0[0]) * u0[0], silu_f(g0[1]) * u0[1]), pack2(silu_f(g0[2]) * u0[2], silu_f(g0[3]) * u0[3]),
                                   pack2(silu_f(g1[0]) * u1[0], silu_f(g1[1]) * u1[1]), pack2(silu_f(g1[2]) * u1[2], silu_f(g1[3]) * u1[3]));
                }
            }
    }
};
struct EpiMoeDown {
    u16* ys; const int* meta; const float* gate;
    DI void operator()(const pg::f32x4 (&acc)[2][2][4][2], const MoeSched::Unit& u, int wr, int wc, int fr, int fq) const {
        const int col0 = u.ns * 256 + wc * 32 + 8 * fq;
#pragma unroll
        for (int ai = 0; ai < 2; ++ai)
#pragma unroll
            for (int m = 0; m < 4; ++m) {
                const int rl = ai * 128 + wr * 64 + m * 16 + fr;
                const int mt = meta[u.slot * 256 + rl]; const float gt = gate[u.slot * 256 + rl];
                if (mt >= 0) {
                    u16* dst = ys + ((size_t)(mt & 1) * NTOK + (mt >> 1)) * DM + col0;
#pragma unroll
                    for (int bj = 0; bj < 2; ++bj) {
                        const pg::f32x4 v0 = acc[ai][bj][m][0], v1 = acc[ai][bj][m][1];
                        *(uint4*)(dst + bj * 128) = make_uint4(pack2(gt * v0[0], gt * v0[1]), pack2(gt * v0[2], gt * v0[3]), pack2(gt * v1[0], gt * v1[1]), pack2(gt * v1[2], gt * v1[3]));
                    }
                }
            }
    }
};
DI void phase_moe(const Params& P, char* lds, bool down) {
    const int tid = threadIdx.x;
    const int nunits = moe_build_table(P, lds);
    const int* tab = (const int*)(lds + MOE_TAB);
    int* rows = (int*)(lds + MOE_ROWS); float* gts = (float*)(lds + MOE_GATE);
    const int* ltok = (const int*)(P.ws + WS_LTOK);
    const float* lgate = (const float*)(P.ws + WS_LGATE);
    const int G8 = gridDim.x >> 3, c8 = blockIdx.x >> 3;
    for (int base = 0; base * G8 + c8 < nunits; base += 8) {
        MoeSched S{tab, (const u16*)(lds + MOE_LIST), rows, down ? (const char*)(P.ws + WS_H) : (const char*)(P.ws + WS_X1B), down ? (const char*)(P.ws + WS_WD) : (const char*)(P.ws + WS_WGU), nunits, G8, c8, base, down};
        for (int i = 0; i < 8; ++i) {
            MoeSched::Unit u;
            if (!S.next(i, u)) break;
            if (tid < 256) {
                const bool ok = tid < u.nvalid;
                const int mt = ok ? ltok[u.e * 16384 + u.rb * 256 + tid] : -1;
                rows[i * 256 + tid] = down ? mt : (ok ? (mt >> 1) : 0);
                if (down) gts[i * 256 + tid] = ok ? lgate[u.e * 16384 + u.rb * 256 + tid] : 0.f;
            }
        }
        __syncthreads();
        if (!down) { EpiMoeUp E{(u16*)(P.ws + WS_H)}; pg::gemm_phase((LAS unsigned char*)lds, S, E, 1024); }
        else { EpiMoeDown E{(u16*)(P.ws + WS_YS), rows, gts}; pg::gemm_phase((LAS unsigned char*)lds, S, E, 512); }
        __syncthreads();
    }
}

DI void phase_ln2(const Params& P) {
    const int tid = threadIdx.x, lane = tid & 63, wid = tid >> 6;
    const float* x1f = (const float*)(P.ws + WS_X1F);
    const u16* ys = (const u16*)(P.ws + WS_YS);
    for (int row = blockIdx.x * 8 + wid; row < NTOK; row += gridDim.x * 8) {
        const size_t rbase = (size_t)row * DM;
        float4 v[4];
#pragma unroll
        for (int j = 0; j < 4; ++j) {
            const int col = lane * 4 + 256 * j;
            const float4 xv = ldnt4(x1f + rbase + col);
            const uint2 a = *(const uint2*)(ys + rbase + col), b2 = *(const uint2*)(ys + (size_t)NTOK * DM + rbase + col);
            v[j].x = ALPHA * xv.x + bflo(a.x) + bflo(b2.x); v[j].y = ALPHA * xv.y + bfhi(a.x) + bfhi(b2.x);
            v[j].z = ALPHA * xv.z + bflo(a.y) + bflo(b2.y); v[j].w = ALPHA * xv.w + bfhi(a.y) + bfhi(b2.y);
        }
        float s = 0.f;
#pragma unroll
        for (int j = 0; j < 4; ++j) s += v[j].x + v[j].y + v[j].z + v[j].w;
        const float mu = wave_sum(s) * (1.f / 1024.f);
        float q = 0.f;
#pragma unroll
        for (int j = 0; j < 4; ++j) { const float a = v[j].x - mu, b2 = v[j].y - mu, c2 = v[j].z - mu, d2 = v[j].w - mu; q += a * a + b2 * b2 + c2 * c2 + d2 * d2; }
        const float rstd = rsqrtf(wave_sum(q) * (1.f / 1024.f) + 1e-5f);
#pragma unroll
        for (int j = 0; j < 4; ++j) {
            const int col = lane * 4 + 256 * j;
            const float4 g = *(const float4*)(P.ln2_g + col), bb = *(const float4*)(P.ln2_b + col);
            float4 o;
            o.x = (v[j].x - mu) * rstd * g.x + bb.x; o.y = (v[j].y - mu) * rstd * g.y + bb.y;
            o.z = (v[j].z - mu) * rstd * g.z + bb.z; o.w = (v[j].w - mu) * rstd * g.w + bb.w;
            stnt4(P.out + rbase + col, o);
        }
    }
}

__global__ void __launch_bounds__(512, 2) fwd_kernel(Params P) {
    extern __shared__ __attribute__((aligned(16))) char lds[];
    volatile LAS unsigned* xbw = (volatile LAS unsigned*)(lds + LDS_BYTES - 16);
    const int lo = P.ph_lo, hi = P.ph_hi;
    XcdBarrier bar;
    if (hi - lo > 1) {
        if (threadIdx.x == 0) { xbw[0] = 0u; xbw[1] = 0u; xbw[2] = 0u; xbw[3] = 0u; }
        __syncthreads();
        bar = xcd_barrier_post((unsigned*)(P.ws + WS_BAR), xbw);
    }
#define IN(k) (lo <= (k) && (k) < hi)
#define SEAM(k) do { if (IN(k) && IN((k) + 1)) xcd_barrier(bar); } while (0)
#define RUN(k, call) do { if (IN(k)) { call; if (REPEAT_PHASE == (k)) { xcd_barrier(bar); \
        if ((k) == 5) { if (blockIdx.x == 0 && threadIdx.x < 64) ((int*)(P.ws + WS_CNT))[threadIdx.x] = 0; xcd_barrier(bar); } call; } } } while (0)
    RUN(0, phase_convert(P));
    SEAM(0);
    RUN(1, phase_inproj(P, lds));
    SEAM(1);
    RUN(2, phase_prep(P, lds));
    SEAM(2);
    RUN(3, phase_scan(P, lds));
    SEAM(3);
    RUN(4, phase_outproj(P, lds));
    SEAM(4);
    RUN(5, phase_ln1_router(P, lds));
    SEAM(5);
    RUN(6, phase_moe(P, lds, false));
    SEAM(6);
    RUN(7, phase_moe(P, lds, true));
    SEAM(7);
    RUN(8, phase_ln2(P));
#undef RUN
#undef IN
#undef SEAM
}

extern "C" void kernel_launch(void* const* d_in, const int* in_sizes, int n_in, void* d_out, int out_size, void* d_ws, size_t ws_size, hipStream_t stream) {
    static int grid = 0;
    if (grid == 0) {
        if (n_in != 21 || in_sizes[0] != NTOK * DM || out_size != NTOK * DM || ws_size < WS_END) {
            fprintf(stderr, "kernel_launch: unexpected shapes (n_in %d, in0 %d, out %d, ws %zu); nothing launched\n", n_in, n_in > 0 ? in_sizes[0] : -1, out_size, ws_size);
            grid = -1; return;
        }
        int dev = 0, cus = 0;
        if (hipGetDevice(&dev) != hipSuccess || hipDeviceGetAttribute(&cus, hipDeviceAttributeMultiprocessorCount, dev) != hipSuccess) { grid = -1; return; }
        if (hipFuncSetAttribute((const void*)fwd_kernel, hipFuncAttributeMaxDynamicSharedMemorySize, LDS_BYTES) != hipSuccess) { fprintf(stderr, "kernel_launch: hipFuncSetAttribute failed\n"); grid = -1; return; }
        int per_cu = 0;
        if (hipOccupancyMaxActiveBlocksPerMultiprocessor(&per_cu, (const void*)fwd_kernel, 512, LDS_BYTES) != hipSuccess || per_cu < 1)
            fprintf(stderr, "kernel_launch: occupancy query reports %d blocks per CU\n", per_cu);
        (void)hipGetLastError();
        grid = cus & ~7;
    }
    if (grid < 0) return;
    (void)hipMemsetAsync(d_ws, 0, 16384 + 1024, stream);
    Params p{};
    const float** pf = (const float**)&p;
    for (int i = 0; i < 21; ++i) pf[i] = (const float*)d_in[i];
    p.out = (float*)d_out; p.ws = (unsigned char*)d_ws;
#if MK_N_LAUNCHES == 1
    p.ph_lo = 0; p.ph_hi = NPHASE;
    hipLaunchKernelGGL(fwd_kernel, dim3(grid), dim3(512), LDS_BYTES, stream, p);
#else
    for (int k = 0; k < NPHASE; ++k) {
        p.ph_lo = k; p.ph_hi = k + 1;
        hipLaunchKernelGGL(fwd_kernel, dim3(grid), dim3(512), LDS_BYTES, stream, p);
    }
#endif
}
```

```cpp
#include <hip/hip_runtime.h>
#include <stdint.h>
#include <stdio.h>
#include <type_traits>

#ifndef MK_N_LAUNCHES
#define MK_N_LAUNCHES 1
#endif

#ifndef REPEAT_PHASE
#define REPEAT_PHASE (-1)
#endif

#define DI __device__ __forceinline__
typedef unsigned short u16;
using bf16x8 = __attribute__((ext_vector_type(8))) __bf16;
using f32x16 = __attribute__((ext_vector_type(16))) float;
using f32x4  = __attribute__((ext_vector_type(4))) float;
using u32x4  = __attribute__((ext_vector_type(4))) unsigned;

constexpr int NTOK = 16384, DM = 1024, SEQ = 2048, NCH = 32;
constexpr int PLD = 3584;
constexpr int C_QA = 0, C_KA = 256, C_VA = 512, C_RA = 1024, C_QB = 1536, C_KB = 2048, C_VB = 2560, C_ZB = 3072;
constexpr int WIN_LD = 3608;
constexpr float ALPHA = 1.189207115002721f;
constexpr int NPHASE = 9;

constexpr size_t MB = 1024 * 1024;
constexpr size_t WS_BAR = 0;
constexpr size_t WS_CNT = 16384;
constexpr size_t WS_WRT = 32768;
constexpr size_t WS_SMALL = 512 * 1024;
constexpr size_t WS_DL = 3 * MB;
constexpr size_t WS_PROJ = 4 * MB;
constexpr size_t WS_YS = 4 * MB;
constexpr size_t WS_X1F = 68 * MB;
constexpr size_t WS_GDN = 116 * MB;
constexpr size_t GDN_UNIT = 73728;
constexpr size_t WS_HBUF = 132 * MB;
constexpr size_t WS_GLA = 188 * MB;
constexpr size_t GLA_UNIT = 24832;
constexpr size_t WS_H = 196 * MB;
constexpr size_t WS_MIXED = 214 * MB;
constexpr size_t WS_WGU = 246 * MB;
constexpr size_t WS_WD = 374 * MB;
constexpr size_t WS_XB = 438 * MB;
constexpr size_t WS_X1B = 438 * MB;
constexpr size_t WS_WINT = 470 * MB;
constexpr size_t WS_WOUTT = 478 * MB;
constexpr size_t WS_LTOK = 480 * MB;
constexpr size_t WS_LGATE = 484 * MB;
constexpr size_t WS_END = 488 * MB;

constexpr int LDS_BYTES = 155648;

struct Params {
    const float *x, *w_in, *w_gk_up, *b_gk, *conv_w, *a_log, *dt_bias, *gla_g, *gdn_g, *w_out, *ln1_g, *ln1_b;
    const float *w_rg, *b_rg, *w_re, *b_re, *w_gate, *w_up, *w_down, *ln2_g, *ln2_b;
    float* out;
    unsigned char* ws;
    int ph_lo, ph_hi;
};

DI u16 f2bf(float x) { return __builtin_bit_cast(u16, (__bf16)x); }
DI float bf2f(u16 v) { return __uint_as_float(((unsigned)v) << 16); }
typedef __bf16 bf16x2_t __attribute__((ext_vector_type(2)));
typedef float f32x2_t __attribute__((ext_vector_type(2)));
typedef unsigned u32x2_t __attribute__((ext_vector_type(2)));
DI unsigned pack2(float a, float b) { const f32x2_t v = {a, b}; return __builtin_bit_cast(unsigned, __builtin_convertvector(v, bf16x2_t)); }
DI float bflo(unsigned v) { return __uint_as_float(v << 16); }
DI float bfhi(unsigned v) { return __uint_as_float(v & 0xffff0000u); }
DI int crow(int i, int h) { return (i & 3) + 8 * (i >> 2) + 4 * h; }
DI float silu_f(float x) { return x / (1.f + __expf(-x)); }
DI f32x16 mfma32(bf16x8 a, bf16x8 b, f32x16 c) { return __builtin_amdgcn_mfma_f32_32x32x16_bf16(a, b, c, 0, 0, 0); }
DI f32x4 mfma16(bf16x8 a, bf16x8 b, f32x4 c) { return __builtin_amdgcn_mfma_f32_16x16x32_bf16(a, b, c, 0, 0, 0); }
DI bf16x8 ld_frag(const char* p) { return __builtin_bit_cast(bf16x8, *(const u32x4*)p); }
DI bf16x8 ld_frag_perm(const char* rowp, int ks, int h) {
    const char* p = rowp + (16 * ks + 4 * h) * 2;
    uint2 lo = *(const uint2*)p, hi = *(const uint2*)(p + 16);
    u32x4 v = {lo.x, lo.y, hi.x, hi.y};
    return __builtin_bit_cast(bf16x8, v);
}
template <int N, int I = 0, class F> DI void static_for(F&& f) {
    if constexpr (I < N) { f(std::integral_constant<int, I>{}); static_for<N, I + 1>(f); }
}
DI bf16x8 ld_frag2(const char* p) {
    const uint2 lo = *(const uint2*)p, hi = *(const uint2*)(p + 16);
    const u32x4 v = {lo.x, lo.y, hi.x, hi.y};
    return __builtin_bit_cast(bf16x8, v);
}
template <int S> DI bf16x8 pack8(const f32x16& x) {
    u32x4 v = {pack2(x[8 * S], x[8 * S + 1]), pack2(x[8 * S + 2], x[8 * S + 3]), pack2(x[8 * S + 4], x[8 * S + 5]), pack2(x[8 * S + 6], x[8 * S + 7])};
    return __builtin_bit_cast(bf16x8, v);
}
DI float dpp_row_shr(float v, int n) {
    const int iv = __builtin_bit_cast(int, v); int r;
    switch (n) { case 1: r = __builtin_amdgcn_update_dpp(0, iv, 0x111, 0xf, 0xf, true); break; case 2: r = __builtin_amdgcn_update_dpp(0, iv, 0x112, 0xf, 0xf, true); break;
                 case 4: r = __builtin_amdgcn_update_dpp(0, iv, 0x114, 0xf, 0xf, true); break; default: r = __builtin_amdgcn_update_dpp(0, iv, 0x118, 0xf, 0xf, true); break; }
    return __builtin_bit_cast(float, r);
}
DI float wave_scan_incl(float v) {
    v += dpp_row_shr(v, 1); v += dpp_row_shr(v, 2); v += dpp_row_shr(v, 4); v += dpp_row_shr(v, 8);
    v += __builtin_bit_cast(float, __builtin_amdgcn_update_dpp(0, __builtin_bit_cast(int, v), 0x142, 0xa, 0xf, false));
    v += __builtin_bit_cast(float, __builtin_amdgcn_update_dpp(0, __builtin_bit_cast(int, v), 0x143, 0xc, 0xf, false));
    return v;
}
DI uint4 ldnt_u4(const void* p) { const u32x4 v = __builtin_nontemporal_load((const u32x4*)p); return make_uint4(v.x, v.y, v.z, v.w); }
DI float4 ldnt4(const float* p) { const f32x4 v = __builtin_nontemporal_load((const f32x4*)p); return make_float4(v.x, v.y, v.z, v.w); }
DI void stnt4(float* p, float4 v) { __builtin_nontemporal_store(f32x4{v.x, v.y, v.z, v.w}, (f32x4*)p); }
DI float wave_sum(float v) {
#pragma unroll
    for (int o = 32; o > 0; o >>= 1) v += __shfl_xor(v, o, 64);
    return v;
}

#define XB_TMO      128
#define XB_XCNT(j)  (256  + 64 * (j))
#define XB_XSUB(j)  (1280 + 64 * (j))
#define XB_XGEN(j)  (2304 + 64 * (j))
#define XB_TOP      3328
#define XB_TOPGEN   3392
#define XCD_BAR_WORDS 3456
#define XB_SPIN_CAP (1u << 18)
#define LAS __attribute__((address_space(3)))

__device__ __forceinline__ unsigned xb_ld(unsigned* p)              { return __hip_atomic_load(p, __ATOMIC_RELAXED, __HIP_MEMORY_SCOPE_AGENT); }
__device__ __forceinline__ unsigned xb_add(unsigned* p, unsigned v) { return __hip_atomic_fetch_add(p, v, __ATOMIC_RELAXED, __HIP_MEMORY_SCOPE_AGENT); }
__device__ __forceinline__ unsigned xb_xcc_id() { return (unsigned)__builtin_amdgcn_s_getreg((3 << 11) | 20) & 0xFu; }
#define XB_SPIN(cond, bar) do { unsigned _sp = 0; while (cond) { __builtin_amdgcn_s_sleep(1); \
    if ((++_sp & 255u) == 0u) { if (xb_ld(&(bar)[XB_TMO])) break; if (_sp > XB_SPIN_CAP) { atomicAdd(&(bar)[XB_TMO], 1u); break; } } } } while (0)

struct XcdBarrier {
    unsigned* bar; unsigned x;
    volatile LAS unsigned* st;
};
__device__ __forceinline__ XcdBarrier xcd_barrier_post(unsigned* bar, volatile LAS unsigned* st) {
    XcdBarrier b; b.bar = bar; b.x = xb_xcc_id(); b.st = st;
    if (threadIdx.x == 0) (void)xb_add(&bar[XB_XCNT(b.x)], 1u);
    return b;
}
__device__ __forceinline__ void xcd_barrier_complete(unsigned* bar, unsigned x, unsigned& nloc, unsigned& nx) {
    const unsigned G = gridDim.x * gridDim.y * gridDim.z;
    unsigned sum, cnt, mine, sp = 0u;
    for (;;) {
        sum = 0u; cnt = 0u; mine = 0u;
#pragma unroll
        for (unsigned j = 0; j < 16; ++j) { const unsigned c = xb_ld(&bar[XB_XCNT(j)]); sum += c; cnt += (c > 0u) ? 1u : 0u; mine = (j == x) ? c : mine; }
        if (sum == G) break;
        __builtin_amdgcn_s_sleep(1);
        if ((++sp & 255u) == 0u) { if (xb_ld(&bar[XB_TMO])) break; if (sp > XB_SPIN_CAP) { atomicAdd(&bar[XB_TMO], 1u); break; } }
    }
    nloc = mine > 0u ? mine : 1u; nx = cnt > 0u ? cnt : 1u;
}
__device__ __forceinline__ void xcd_barrier(const XcdBarrier& b) {
    asm volatile("s_waitcnt vmcnt(0)" ::: "memory");
    __syncthreads();
    if (threadIdx.x == 0) {
        unsigned* bar = b.bar;
        __builtin_amdgcn_s_waitcnt(0);
        unsigned nloc = b.st[0], nx = b.st[1];
        if (nloc == 0u) { xcd_barrier_complete(bar, b.x, nloc, nx); b.st[0] = nloc; b.st[1] = nx; }
        const unsigned old = xb_add(&bar[XB_XSUB(b.x)], 1u);
        const unsigned gen = old / nloc;
        if (old + 1u == (gen + 1u) * nloc) {
            __builtin_amdgcn_fence(__ATOMIC_RELEASE, "agent");
            asm volatile("s_waitcnt vmcnt(0)" ::: "memory");
            const unsigned og = xb_add(&bar[XB_TOP], 1u);
            const unsigned tg = og / nx;
            if (og + 1u == (tg + 1u) * nx) xb_add(&bar[XB_TOPGEN], 1u);
            else XB_SPIN(xb_ld(&bar[XB_TOPGEN]) == tg, bar);
            __builtin_amdgcn_fence(__ATOMIC_ACQUIRE, "agent");
            xb_add(&bar[XB_XGEN(b.x)], 1u);
            asm volatile("s_waitcnt vmcnt(0)" ::: "memory");
        } else {
            XB_SPIN(xb_ld(&bar[XB_XGEN(b.x)]) == gen, bar);
            __builtin_amdgcn_fence(__ATOMIC_ACQUIRE, "agent");
            asm volatile("s_waitcnt vmcnt(0)" ::: "memory");
        }
    }
    __syncthreads();
}

namespace pg {
typedef float f32x4 __attribute__((ext_vector_type(4)));
typedef short s16x8 __attribute__((ext_vector_type(8)));
constexpr int BK = 64, HALF = 128, HTB = HALF * BK * 2, STAGE_BYTES = 8 * HTB;
DI int lds_byte(int r, int c) { const int st = (r >> 4) * 2 + (c >> 5), rr = r & 15, cc = c & 31, ob = rr * 64 + cc * 2; return st * 1024 + (ob ^ (((ob >> 9) & 1) << 5)); }
DI void stage_rc(int b, int& R, int& C) { const int st = b / 1024, sb = b % 1024, swz = sb ^ (((sb >> 9) & 1) << 5); R = (st >> 1) * 16 + swz / 64; C = (st & 1) * 32 + (swz % 64) / 2; }
DI int perm32(int rho) { const int n = rho >> 4, i = rho & 15; return 8 * (i >> 2) + 4 * n + (i & 3); }

template <class Epi, class Sched>
DI void gemm_phase(LAS unsigned char* lds, const Sched& S, const Epi& E, const int K) {
    const int tid = threadIdx.x, wid = __builtin_amdgcn_readfirstlane(tid >> 6), lane = tid & 63, wr = wid >> 2, wc = wid & 3, fr = lane & 15, fq = lane >> 4;
    const int nt = K / BK;
    int RA[2], CA[2]; unsigned voffB[2];
#pragma unroll
    for (int i = 0; i < 2; ++i) { int R, C; stage_rc(tid * 16 + i * 8192, R, C); RA[i] = R; CA[i] = C; const int Rb = (R & ~31) + perm32(R & 31); voffB[i] = (unsigned)(Rb * K + C) * 2u; }
    const size_t kstep = (size_t)(BK * 2);
    const size_t hstepB = (size_t)HALF * K * 2;
    const unsigned ldsw = (unsigned)wid * 1024u;
    const int aoff = lds_byte(wr * 64 + fr, fq * 8), boff = lds_byte(wc * 32 + fr, fq * 8);
#define PG_SA(b, h) (((b) * 2 + (h)) * HTB)
#define PG_SB(b, h) ((4 + (b) * 2 + (h)) * HTB)
#define PG_STAGE(bufoff, gbase, voff) do { _Pragma("unroll") for (int _i = 0; _i < 2; ++_i) \
        __builtin_amdgcn_global_load_lds((const unsigned*)((const char*)(gbase) + (voff)[_i]), (LAS unsigned*)(lds + (bufoff) + ldsw + _i * 8192), 16, 0, 0); } while (0)
#define PG_LDA(dst, b, h) do { _Pragma("unroll") for (int m = 0; m < 4; ++m) _Pragma("unroll") for (int k = 0; k < 2; ++k) dst[m][k] = *(const LAS s16x8*)(lds + PG_SA(b, h) + aoff + m * 2048 + k * 1024); } while (0)
#define PG_LDB(dst, b, h) do { _Pragma("unroll") for (int n = 0; n < 2; ++n) _Pragma("unroll") for (int k = 0; k < 2; ++k) dst[n][k] = *(const LAS s16x8*)(lds + PG_SB(b, h) + boff + n * 2048 + k * 1024); } while (0)
#define PG_MMA(ai, bj, At, Bt) do { if ((ai) == 1 && skip1) break; __builtin_amdgcn_s_setprio(1); _Pragma("unroll") for (int m = 0; m < 4; ++m) _Pragma("unroll") for (int n = 0; n < 2; ++n) _Pragma("unroll") for (int k = 0; k < 2; ++k) \
        acc[ai][bj][m][n] = __builtin_amdgcn_mfma_f32_16x16x32_bf16(__builtin_bit_cast(bf16x8, Bt[n][k]), __builtin_bit_cast(bf16x8, At[m][k]), acc[ai][bj][m][n], 0, 0, 0); __builtin_amdgcn_s_setprio(0); } while (0)
#define PG_WAIT_V(n) asm volatile("s_waitcnt vmcnt(" #n ")" ::: "memory")
#define PG_WAIT_L(n) asm volatile("s_waitcnt lgkmcnt(" #n ")" ::: "memory")
#define PG_BAR __builtin_amdgcn_s_barrier()
#define PG_SCHED __builtin_amdgcn_sched_barrier(0)
    typename Sched::Unit cur, nxt; int ui = 0;
    if (!S.next(0, cur)) return;
    f32x4 acc[2][2][4][2];
#pragma unroll
    for (int a = 0; a < 2; ++a)
#pragma unroll
        for (int b = 0; b < 2; ++b)
#pragma unroll
            for (int m = 0; m < 4; ++m)
#pragma unroll
                for (int n = 0; n < 2; ++n) acc[a][b][m][n] = (f32x4){0.f, 0.f, 0.f, 0.f};
    s16x8 At[4][2], B0[2][2], B1[2][2];
    const char* cA; const char* cB; unsigned vA[2][2];
    S.addr(cur, RA, CA, cA, vA, cB);
    bool skip1 = Sched::half1_empty(cur);
    PG_STAGE(PG_SB(0, 0), cB, voffB); PG_STAGE(PG_SA(0, 0), cA, vA[0]); PG_STAGE(PG_SB(0, 1), cB + hstepB, voffB); PG_STAGE(PG_SA(0, 1), cA, vA[1]);
    if (wr == 1) PG_BAR;
    PG_WAIT_V(4); PG_BAR;
    PG_STAGE(PG_SB(1, 0), cB + kstep, voffB); PG_STAGE(PG_SA(1, 0), cA + kstep, vA[0]); PG_STAGE(PG_SB(1, 1), cB + hstepB + kstep, voffB);
    PG_WAIT_V(6); PG_BAR;
    for (;;) {
        const bool has_next = S.next(ui + 1, nxt);
        const char* nA = cA; const char* nB = cB; unsigned vN[2][2] = {{vA[0][0], vA[0][1]}, {vA[1][0], vA[1][1]}};
        if (has_next) S.addr(nxt, RA, CA, nA, vN, nB);
        for (int t = 0; t < nt; t += 2) {
            const bool last = (t == nt - 2);
            const char* a1 = cA + (size_t)(t + 1) * kstep;
            const char* a2 = last ? nA : cA + (size_t)(t + 2) * kstep; const char* b2 = last ? nB : cB + (size_t)(t + 2) * kstep;
            const char* a3 = a2 + kstep; const char* b3 = b2 + kstep;
            unsigned w0[2], w1[2];
            w0[0] = last ? vN[0][0] : vA[0][0]; w0[1] = last ? vN[0][1] : vA[0][1]; w1[0] = last ? vN[1][0] : vA[1][0]; w1[1] = last ? vN[1][1] : vA[1][1];
            PG_LDB(B0, 0, 0); PG_SCHED; PG_LDA(At, 0, 0); PG_STAGE(PG_SA(1, 1), a1, vA[1]);
            PG_WAIT_L(8); PG_BAR; PG_WAIT_L(0); PG_MMA(0, 0, At, B0); PG_BAR; PG_SCHED;
            PG_LDB(B1, 0, 1); PG_STAGE(PG_SB(0, 0), b2, voffB);
            PG_BAR; PG_WAIT_L(0); PG_MMA(0, 1, At, B1); PG_BAR;
            PG_LDA(At, 0, 1); PG_STAGE(PG_SA(0, 0), a2, w0);
            PG_BAR; PG_WAIT_L(0); PG_MMA(1, 0, At, B0); PG_BAR; PG_SCHED;
            PG_STAGE(PG_SB(0, 1), b2 + hstepB, voffB);
            PG_WAIT_V(6); PG_BAR; PG_MMA(1, 1, At, B1); PG_BAR;
            PG_LDB(B0, 1, 0); PG_SCHED; PG_LDA(At, 1, 0); PG_STAGE(PG_SA(0, 1), a2, w1);
            PG_WAIT_L(8); PG_BAR; PG_WAIT_L(0); PG_MMA(0, 0, At, B0); PG_BAR; PG_SCHED;
            PG_LDB(B1, 1, 1); PG_STAGE(PG_SB(1, 0), b3, voffB);
            PG_BAR; PG_WAIT_L(0); PG_MMA(0, 1, At, B1); PG_BAR;
            PG_LDA(At, 1, 1); PG_STAGE(PG_SA(1, 0), a3, w0);
            PG_BAR; PG_WAIT_L(0); PG_MMA(1, 0, At, B0); PG_BAR; PG_SCHED;
            PG_STAGE(PG_SB(1, 1), b3 + hstepB, voffB);
            PG_WAIT_V(6); PG_BAR; PG_MMA(1, 1, At, B1); PG_BAR;
        }
        E(acc, cur, wr, wc, fr, fq);
        if (!has_next) break;
#pragma unroll
        for (int a = 0; a < 2; ++a)
#pragma unroll
            for (int b = 0; b < 2; ++b)
#pragma unroll
                for (int m = 0; m < 4; ++m)
#pragma unroll
                    for (int n = 0; n < 2; ++n) acc[a][b][m][n] = (f32x4){0.f, 0.f, 0.f, 0.f};
        cur = nxt; cA = nA; cB = nB; ++ui; skip1 = Sched::half1_empty(cur);
        vA[0][0] = vN[0][0]; vA[0][1] = vN[0][1]; vA[1][0] = vN[1][0]; vA[1][1] = vN[1][1];
    }
    PG_WAIT_V(0);
    if (wr == 0) PG_BAR;
    PG_BAR;
#undef PG_SA
#undef PG_SB
#undef PG_STAGE
#undef PG_LDA
#undef PG_LDB
#undef PG_MMA
#undef PG_WAIT_V
#undef PG_WAIT_L
#undef PG_BAR
#undef PG_SCHED
}

struct DenseSched {
    struct Unit { int pm, pn; };
    static DI bool half1_empty(const Unit&) { return false; }
    const char* A; const char* Bt; int K, nM, nN, G, c;
    DI bool next(int i, Unit& u) const {
        const int nwg = nM * nN; const long L = (long)i * G + c; if (L >= nwg) return false;
        int wgid = (int)L; { const int q = nwg / 8, r = nwg % 8, xcd = wgid % 8, off = wgid / 8; wgid = (xcd < r ? xcd * (q + 1) : r * (q + 1) + (xcd - r) * q) + off; }
        const int nig = 8 * nN, gid = wgid / nig, fm = gid * 8, gsz = (nM - fm) < 8 ? (nM - fm) : 8;
        u.pm = fm + ((wgid % nig) % gsz); u.pn = (wgid % nig) / gsz; return true;
    }
    DI void addr(const Unit& u, const int (&R)[2], const int (&C)[2], const char*& aBase, unsigned (&vA)[2][2], const char*& bBase) const {
        aBase = A + (size_t)u.pm * 256 * K * 2; bBase = Bt + (size_t)u.pn * 256 * K * 2;
#pragma unroll
        for (int h = 0; h < 2; ++h)
#pragma unroll
            for (int i = 0; i < 2; ++i) vA[h][i] = (unsigned)((h * 128 + R[i]) * K + C[i]) * 2u;
    }
};
}

DI void transpose_block(const float* src, size_t lds_, bool valid, u16* d0, u16* d1, u16* d2, u16* d3) {
    f32x4 v[8];
#pragma unroll
    for (int j = 0; j < 8; ++j) v[j] = valid ? __builtin_nontemporal_load((const f32x4*)(src + (size_t)j * lds_)) : f32x4{0.f, 0.f, 0.f, 0.f};
    __builtin_nontemporal_store(u32x4{pack2(v[0].x, v[1].x), pack2(v[2].x, v[3].x), pack2(v[4].x, v[5].x), pack2(v[6].x, v[7].x)}, (u32x4*)d0);
    __builtin_nontemporal_store(u32x4{pack2(v[0].y, v[1].y), pack2(v[2].y, v[3].y), pack2(v[4].y, v[5].y), pack2(v[6].y, v[7].y)}, (u32x4*)d1);
    __builtin_nontemporal_store(u32x4{pack2(v[0].z, v[1].z), pack2(v[2].z, v[3].z), pack2(v[4].z, v[5].z), pack2(v[6].z, v[7].z)}, (u32x4*)d2);
    __builtin_nontemporal_store(u32x4{pack2(v[0].w, v[1].w), pack2(v[2].w, v[3].w), pack2(v[4].w, v[5].w), pack2(v[6].w, v[7].w)}, (u32x4*)d3);
}

DI void phase_convert(const Params& P) {
    const int tid = threadIdx.x, lane = tid & 63, wid = tid >> 6, kq = lane & 7, ng = lane >> 3;
    if (blockIdx.x == 0 && tid < 64) ((int*)(P.ws + WS_CNT))[tid] = 0;
    {
        u16* hi = (u16*)(P.ws + WS_WRT); u16* lo = hi + 80 * 1024;
        for (int idx = blockIdx.x * 512 + tid; idx < 80 * 1024; idx += gridDim.x * 512) {
            const int n = idx >> 10, k = idx & 1023;
            float w = 0.f;
            if (n < 8) w = P.w_rg[k * 8 + n]; else if (n < 72) w = P.w_re[k * 64 + (n - 8)];
            const u16 hb = f2bf(w);
            hi[idx] = hb; lo[idx] = f2bf(w - bf2f(hb));
        }
    }
    u16* wint = (u16*)(P.ws + WS_WINT); u16* woutt = (u16*)(P.ws + WS_WOUTT);
    const int gw = blockIdx.x * 8 + wid, nw = gridDim.x * 8;
    for (int T = gw; T < 1920 + 512; T += nw) {
        if (T < 1920) {
            const int kb = T / 120, nb = T - kb * 120;
            const int n4 = 32 * nb + 4 * ng;
            int src; bool valid = true;
            if (n4 < 1536) src = n4; else if (n4 < 3584) src = n4 + 16; else if (n4 < 3600) src = 1536 + (n4 - 3584); else if (n4 < 3608) src = n4; else { src = 0; valid = false; }
            u16* d = wint + (size_t)n4 * 1024 + 64 * kb + 8 * kq;
            transpose_block(P.w_in + (size_t)(64 * kb + 8 * kq) * WIN_LD + src, WIN_LD, valid, d, d + 1024, d + 2048, d + 3072);
        } else {
            const int t2 = T - 1920, kb = t2 >> 5, nb = t2 & 31;
            const int n4 = 32 * nb + 4 * ng;
            u16* d = woutt + (size_t)n4 * 1024 + 64 * kb + 8 * kq;
            transpose_block(P.w_out + (size_t)(64 * kb + 8 * kq) * DM + n4, DM, true, d, d + 1024, d + 2048, d + 3072);
        }
    }
    {
        uint2* xb = (uint2*)(P.ws + WS_XB);
        const int gwv = blockIdx.x * 8 + wid, nwv = gridDim.x * 8;
        float4 va[2][4];
#define XC_FETCH(r_) do { _Pragma("unroll") for (int rr = 0; rr < 2; ++rr) _Pragma("unroll") for (int j = 0; j < 4; ++j) va[rr][j] = ldnt4(P.x + (size_t)((r_) + rr) * DM + lane * 4 + 256 * j); } while (0)
        int r = gwv * 2;
        if (r < NTOK) XC_FETCH(r);
        for (; r < NTOK; r += nwv * 2) {
            float4 vc[2][4];
#pragma unroll
            for (int rr = 0; rr < 2; ++rr)
#pragma unroll
                for (int j = 0; j < 4; ++j) vc[rr][j] = va[rr][j];
            if (r + nwv * 2 < NTOK) XC_FETCH(r + nwv * 2);
#pragma unroll
            for (int rr = 0; rr < 2; ++rr)
#pragma unroll
                for (int j = 0; j < 4; ++j) xb[((size_t)(r + rr) * DM + lane * 4 + 256 * j) >> 2] = make_uint2(pack2(vc[rr][j].x, vc[rr][j].y), pack2(vc[rr][j].z, vc[rr][j].w));
        }
#undef XC_FETCH
    }
}

DI void convert_experts(const Params& P, int first_wave, int n_waves) {
    const int tid = threadIdx.x, lane = tid & 63, kq = lane & 7, ng = lane >> 3;
    u16* wgu = (u16*)(P.ws + WS_WGU); u16* wd = (u16*)(P.ws + WS_WD);
    for (int T = first_wave; T < 192 * 256; T += n_waves) {
        const int mat = T >> 8, t2 = T & 255;
        const int e = mat / 3, which = mat - e * 3;
        if (which < 2) {
            const int kb = t2 >> 4, nb = t2 & 15;
            const int n4 = 32 * nb + 4 * ng;
            const float* src = (which ? P.w_up : P.w_gate) + (size_t)e * (1024 * 512) + (size_t)(64 * kb + 8 * kq) * 512 + n4;
            u16* d = wgu + ((size_t)(e * 4 + (n4 >> 7)) * 256 + which * 128 + (n4 & 127)) * 1024 + 64 * kb + 8 * kq;
            transpose_block(src, 512, true, d, d + 1024, d + 2048, d + 3072);
        } else {
            const int kb = t2 >> 5, nb = t2 & 31;
            const int n4 = 32 * nb + 4 * ng;
            const float* src = P.w_down + (size_t)e * (512 * 1024) + (size_t)(64 * kb + 8 * kq) * 1024 + n4;
            u16* d = wd + ((size_t)e * 1024 + n4) * 512 + 64 * kb + 8 * kq;
            transpose_block(src, 1024, true, d, d + 512, d + 1024, d + 1536);
        }
    }
}

struct EpiInproj {
    u16* proj; float* small;
    DI void operator()(const pg::f32x4 (&acc)[2][2][4][2], const pg::DenseSched::Unit& u, int wr, int wc, int fr, int fq) const {
        const int row0 = u.pm * 256 + wr * 64 + fr;
        if (u.pn < 14) {
            const int col0 = u.pn * 256 + wc * 32 + 8 * fq;
#pragma unroll
            for (int ai = 0; ai < 2; ++ai)
#pragma unroll
                for (int m = 0; m < 4; ++m) {
                    u16* rowp = proj + (size_t)(row0 + ai * 128 + m * 16) * PLD + col0;
#pragma unroll
                    for (int bj = 0; bj < 2; ++bj) {
                        const pg::f32x4 v0 = acc[ai][bj][m][0], v1 = acc[ai][bj][m][1];
                        *(uint4*)(rowp + bj * 128) = make_uint4(pack2(v0[0], v0[1]), pack2(v0[2], v0[3]), pack2(v1[0], v1[1]), pack2(v1[2], v1[3]));
                    }
                }
        } else if (wc == 0 && fq < 3) {
#pragma unroll
            for (int ai = 0; ai < 2; ++ai)
#pragma unroll
                for (int m = 0; m < 4; ++m) {
                    float* rowp = small + (size_t)(row0 + ai * 128 + m * 16) * 24 + 8 * fq;
                    const pg::f32x4 v0 = acc[ai][0][m][0], v1 = acc[ai][0][m][1];
                    *(float4*)rowp = make_float4(v0[0], v0[1], v0[2], v0[3]); *(float4*)(rowp + 4) = make_float4(v1[0], v1[1], v1[2], v1[3]);
                }
        }
    }
};
DI void phase_inproj(const Params& P, char* lds) {
    pg::DenseSched S{(const char*)(P.ws + WS_XB), (const char*)(P.ws + WS_WINT), DM, 64, 15, (int)gridDim.x, (int)blockIdx.x};
    EpiInproj E{(u16*)(P.ws + WS_PROJ), (float*)(P.ws + WS_SMALL)};
    pg::gemm_phase(( LAS unsigned char*)lds, S, E, DM);
}

constexpr int PG_RAWQ = 0, PG_RAWK = 33792, PG_AMAT = 0, PG_T = 17408, PG_KN = 67584, PG_QN = 84992, PG_RT = 102400, PG_MISC = 139264;

constexpr int PGL_QE = 26624, PGL_KE = 35840, PGL_TB = 45056, PGL_W = 140288;
struct GlaIn { f32x4 l[4]; u32x4 q[2], k[2]; };
DI void gla_shadow(const Params& P, char* lds, int U, int wq, int lane, const GlaIn& gi);
DI void gla_attn_tiles(const Params& P, char* lds, int U, int wid, int lane);
struct PrepPre { u32x4 xin[11]; float bbv, abv; f32x4 gwv; float gb; };
DI void prep_prefetch(const Params& P, int U, int tid, PrepPre& pre) {
    const int c = U & 31, hd = (U >> 5) & 3, b = U >> 7;
    const int t0 = b * SEQ + c * 64;
    const u16* proj = (const u16*)(P.ws + WS_PROJ);
    const float* small = (const float*)(P.ws + WS_SMALL);
    if (tid < 384) {
        const int cg = tid % 48, pb = tid / 48;
        const int col = C_QB + (cg >> 4) * 512 + hd * 128 + (cg & 15) * 8;
#pragma unroll
        for (int j = 0; j < 11; ++j) {
            const int pos = pb * 8 - 3 + j;
            if (pos >= 0 || c > 0) pre.xin[j] = *(const u32x4*)(proj + (size_t)(t0 + pos) * PLD + col);
            else pre.xin[j] = u32x4{0u, 0u, 0u, 0u};
        }
    }
    if (tid < 64) { pre.bbv = small[(size_t)(t0 + tid) * 24 + 16 + hd]; pre.abv = small[(size_t)(t0 + tid) * 24 + 20 + hd]; }
    if (tid >= 256) {
        const int lt = tid - 256;
        pre.gwv = *(const f32x4*)(P.w_gk_up + (lt >> 4) * 256 + hd * 64 + (lt & 15) * 4);
        if (lt < 64) pre.gb = P.b_gk[hd * 64 + lt];
    }
}
DI void gdn_prep_unit(const Params& P, char* lds, int U, PrepPre& pre, int Unext) {
    int tidv = threadIdx.x;
    asm volatile("" : "+v"(tidv));
    const int tid = tidv, lane = tid & 63, wid = __builtin_amdgcn_readfirstlane(tid >> 6), r = lane & 31, h5 = lane >> 5;
    const int c = U & 31, hd = (U >> 5) & 3, b = U >> 7;
    const int t0 = b * SEQ + c * 64;
    const u16* proj = (const u16*)(P.ws + WS_PROJ);
    const float* small = (const float*)(P.ws + WS_SMALL);
    unsigned char* ub = P.ws + WS_GDN + (size_t)U * GDN_UNIT;
    u16* g_negw = (u16*)ub; u16* g_qd = (u16*)(ub + 16384); u16* g_kdt = (u16*)(ub + 32768); u16* g_attn = (u16*)(ub + 49152); u16* g_uf = (u16*)(ub + 57344);
    float* rawq = (float*)(lds + PG_RAWQ); float* rawk = (float*)(lds + PG_RAWK);
    float* amat = (float*)(lds + PG_AMAT);
    float* sgam = (float*)(lds + PG_MISC); float* sbeta = sgam + 64; float* srq = sgam + 128; float* srk = sgam + 192;

    GlaIn gin;
    if (wid >= 1 && wid <= 4) {
        const int tg = t0 + lane, dg = 16 * (wid - 1);
#pragma unroll
        for (int q = 0; q < 4; ++q) gin.l[q] = *(const f32x4*)(small + (size_t)tg * 24 + 4 * q);
        gin.q[0] = *(const u32x4*)(proj + (size_t)tg * PLD + C_QA + hd * 64 + dg); gin.q[1] = *(const u32x4*)(proj + (size_t)tg * PLD + C_QA + hd * 64 + dg + 8);
        gin.k[0] = *(const u32x4*)(proj + (size_t)tg * PLD + C_KA + hd * 64 + dg); gin.k[1] = *(const u32x4*)(proj + (size_t)tg * PLD + C_KA + hd * 64 + dg + 8);
    }
    if (wid >= 4) {
        const int lt = tid - 256;
        float* gw = (float*)(lds + PGL_W);
        *(f32x4*)(gw + lt * 4) = pre.gwv;
        if (lt < 64) gw[1024 + lt] = pre.gb;
    }
    if (wid == 0) {
        const float bbv = pre.bbv, abv = pre.abv;
        const float z = abv + P.dt_bias[hd];
        const float sp = z > 20.f ? z : (z < -15.f ? __expf(z) : __logf(1.f + __expf(z)));
        float g = -__expf(P.a_log[hd]) * sp;
        g = wave_scan_incl(g);
        sgam[lane] = g; sbeta[lane] = 1.f / (1.f + __expf(-bbv));
    }
    __syncthreads();
    if (tid < 384) {
        const int cg = tid % 48, pb = tid / 48;
        const int which = cg >> 4, d0 = (cg & 15) * 8;
        const int col = C_QB + which * 512 + hd * 128 + d0;
        const int cch = which * 512 + hd * 128 + d0;
        float w[4][8];
#pragma unroll
        for (int i = 0; i < 4; ++i) {
            const float4 a = *(const float4*)(P.conv_w + i * 1536 + cch), b2 = *(const float4*)(P.conv_w + i * 1536 + cch + 4);
            w[i][0] = a.x; w[i][1] = a.y; w[i][2] = a.z; w[i][3] = a.w; w[i][4] = b2.x; w[i][5] = b2.y; w[i][6] = b2.z; w[i][7] = b2.w;
        }
        float sv[8][8];
#pragma unroll
        for (int p = 0; p < 8; ++p) {
#pragma unroll
            for (int ch2 = 0; ch2 < 4; ++ch2) {
                float y0 = 0.f, y1 = 0.f;
#pragma unroll
                for (int i = 0; i < 4; ++i) {
                    const u32x4 xr = pre.xin[p + i];
                    const unsigned xw = ch2 == 0 ? xr.x : (ch2 == 1 ? xr.y : (ch2 == 2 ? xr.z : xr.w));
                    y0 += w[i][2 * ch2] * bflo(xw); y1 += w[i][2 * ch2 + 1] * bfhi(xw);
                }
                sv[p][2 * ch2] = silu_f(y0); sv[p][2 * ch2 + 1] = silu_f(y1);
            }
        }
        if (which < 2) {
            float* dst = (which ? rawk : rawq) + (pb * 8) * 132 + d0;
#pragma unroll
            for (int p = 0; p < 8; ++p) {
                *(float4*)(dst + p * 132) = make_float4(sv[p][0], sv[p][1], sv[p][2], sv[p][3]);
                *(float4*)(dst + p * 132 + 4) = make_float4(sv[p][4], sv[p][5], sv[p][6], sv[p][7]);
            }
        } else {
            float bt[8];
#pragma unroll
            for (int p = 0; p < 8; ++p) bt[p] = sbeta[pb * 8 + p];
#pragma unroll
            for (int ch = 0; ch < 8; ++ch)
                *(uint4*)(lds + PG_RT + (d0 + ch) * 144 + pb * 16) =
                    make_uint4(pack2(bt[0] * sv[0][ch], bt[1] * sv[1][ch]), pack2(bt[2] * sv[2][ch], bt[3] * sv[3][ch]), pack2(bt[4] * sv[4][ch], bt[5] * sv[5][ch]), pack2(bt[6] * sv[6][ch], bt[7] * sv[7][ch]));
        }
    }
    __syncthreads();
    if (tid < 128) {
        const int pos = tid & 63, which = tid >> 6;
        const float* src = (which ? rawk : rawq) + pos * 132;
        float ss = 0.f;
#pragma unroll 8
        for (int d = 0; d < 128; d += 4) { const float4 v = *(const float4*)(src + d); ss += v.x * v.x + v.y * v.y + v.z * v.z + v.w * v.w; }
        const float rn = rsqrtf(ss + 1e-6f);
        if (which) srk[pos] = rn; else srq[pos] = rn * 0.08838834764831845f;
    }
    __syncthreads();
    {
        const int d = tid & 127, pq = tid >> 7;
        const float glast = sgam[63];
        unsigned kd[8], rt[8];
#pragma unroll
        for (int j2 = 0; j2 < 8; ++j2) {
            float kdv[2], rtv[2];
#pragma unroll
            for (int e = 0; e < 2; ++e) {
                const int pos = pq * 16 + j2 * 2 + e;
                const float gm = sgam[pos];
                const float eg = __expf(gm), ek = __expf(glast - gm);
                const float kn = rawk[pos * 132 + d] * srk[pos];
                const float qn = rawq[pos * 132 + d] * srq[pos];
                *(u16*)(lds + PG_KN + pos * 272 + d * 2) = f2bf(kn);
                *(u16*)(lds + PG_QN + pos * 272 + d * 2) = f2bf(qn);
                g_qd[pos * 128 + d] = f2bf(qn * eg);
                kdv[e] = kn * ek; rtv[e] = sbeta[pos] * kn * eg;
            }
            kd[j2] = pack2(kdv[0], kdv[1]); rt[j2] = pack2(rtv[0], rtv[1]);
        }
        uint4* kp = (uint4*)(g_kdt + d * 64 + pq * 16);
        kp[0] = make_uint4(kd[0], kd[1], kd[2], kd[3]); kp[1] = make_uint4(kd[4], kd[5], kd[6], kd[7]);
        uint4* rp = (uint4*)(lds + PG_RT + (128 + d) * 144 + pq * 32);
        rp[0] = make_uint4(rt[0], rt[1], rt[2], rt[3]); rp[1] = make_uint4(rt[4], rt[5], rt[6], rt[7]);
        if (tid == 0) ((float*)(P.ws + WS_DL))[U] = __expf(glast);
    }
    __syncthreads();
    {
        const int which = wid >> 2, ti = (wid >> 1) & 1, tj = wid & 1;
        f32x16 acc;
#pragma unroll
        for (int i = 0; i < 16; ++i) acc[i] = 0.f;
        if (!(ti == 0 && tj == 1)) {
            const char* xa = lds + (which ? PG_QN : PG_KN) + (32 * ti + r) * 272 + h5 * 16;
            const char* xb = lds + PG_KN + (32 * tj + r) * 272 + h5 * 16;
#pragma unroll
            for (int ks = 0; ks < 8; ++ks) acc = mfma32(ld_frag(xa + ks * 32), ld_frag(xb + ks * 32), acc);
        }
        const int j = 32 * tj + r;
        const float gj = sgam[j];
#pragma unroll
        for (int i = 0; i < 16; ++i) {
            const int ii = 32 * ti + crow(i, h5);
            const float dec = __expf(fminf(sgam[ii] - gj, 0.f));
            if (which == 0) amat[ii * 68 + j] = (j < ii) ? sbeta[ii] * acc[i] * dec : 0.f;
            else g_attn[ii * 64 + j] = f2bf((j <= ii) ? acc[i] * dec : 0.f);
        }
    }
    __syncthreads();
    if (Unext >= 0 && wid != 0) prep_prefetch(P, Unext, tid, pre);
    if (wid == 0) {
        const int hb = lane >> 5, cb = lane & 31;
        const float* ab = amat + (32 * hb) * 68 + 32 * hb;
        float* tbs = (float*)(lds + PGL_TB) + hb * (32 * 33);
        float t[32];
        float4 an[8], ac[8];
        float dn = 0.f, dc;
#define INV_LOAD(i, dst) do { _Pragma("unroll") for (int q = 0; q < 8; ++q) if (q < ((i) + 3) / 4) dst[q] = *(const float4*)(ab + abo + (i) * 68 + 4 * q); } while (0)
        dc = ab[cb];
#pragma unroll
        for (int q = 0; q < 8; ++q) { ac[q] = make_float4(0.f, 0.f, 0.f, 0.f); an[q] = make_float4(0.f, 0.f, 0.f, 0.f); }
        int abo = 0;
#pragma unroll
        for (int i = 0; i < 32; ++i) {
            { const float tp = (i > 0) ? t[i > 0 ? i - 1 : 0] : dc; asm volatile("" : "+v"(abo) : "v"(tp)); }
            if (i + 1 < 32) { dn = (ab + abo)[(i + 1) * 68 + cb]; INV_LOAD(i + 1, an); }
            __builtin_amdgcn_sched_barrier(0);
            float s0 = -dc, s1 = 0.f;
#pragma unroll
            for (int q = 0; q < 8; ++q) { const int j = 4 * q;
                if (j + 0 < i) s0 -= ac[q].x * t[j + 0]; if (j + 1 < i) s1 -= ac[q].y * t[j + 1];
                if (j + 2 < i) s0 -= ac[q].z * t[j + 2]; if (j + 3 < i) s1 -= ac[q].w * t[j + 3]; }
            t[i] = s0 + s1; dc = dn;
            __builtin_amdgcn_sched_barrier(0);
#pragma unroll
            for (int q = 0; q < 8; ++q) ac[q] = an[q];
        }
#undef INV_LOAD
#pragma unroll
        for (int i = 0; i < 32; ++i) {
            *(u16*)(lds + PG_T + (32 * hb + i) * 144 + (32 * hb + cb) * 2) = f2bf(t[i]);
            tbs[i * 33 + cb] = t[i];
            if (hb) *(u16*)(lds + PG_T + i * 144 + (32 + cb) * 2) = (u16)0;
        }
        *(u16*)(lds + PG_T + lane * 144 + lane * 2) = (u16)0x3F80;
        tbs[cb * 33 + cb] = 1.f;
        const float* t11 = (const float*)(lds + PGL_TB); const float* t22 = t11 + 32 * 33;
        f32x16 ax, at;
#pragma unroll
        for (int i = 0; i < 16; ++i) { ax[i] = 0.f; at[i] = 0.f; }
        static_for<16>([&](auto skc) {
            constexpr int sk = decltype(skc)::value;
            ax = __builtin_amdgcn_mfma_f32_32x32x2f32(amat[(32 + cb) * 68 + 2 * sk + hb], t11[(2 * sk + hb) * 33 + cb], ax, 0, 0, 0);
        });
        static_for<16>([&](auto skc) {
            constexpr int sk = decltype(skc)::value;
            constexpr int r0 = (sk & 3) + 8 * (sk >> 2);
            at = __builtin_amdgcn_mfma_f32_32x32x2f32(t22[cb * 33 + r0 + 4 * hb], ax[sk], at, 0, 0, 0);
        });
#pragma unroll
        for (int i = 0; i < 16; ++i) *(u16*)(lds + PG_T + (32 + crow(i, hb)) * 144 + cb * 2) = f2bf(-at[i]);
        if (Unext >= 0) prep_prefetch(P, Unext, tid, pre);
    } else if (wid <= 4) {
        gla_shadow(P, lds, U, wid - 1, lane, gin);
    }
    __syncthreads();
    if (wid < 4) gla_attn_tiles(P, lds, U, wid, lane);
    {
        f32x16 acc[2];
#pragma unroll
        for (int m = 0; m < 2; ++m)
#pragma unroll
            for (int i = 0; i < 16; ++i) acc[m][i] = 0.f;
        const char* tb = lds + PG_T + r * 144 + h5 * 16;
        const char* rb = lds + PG_RT + (32 * wid + r) * 144 + h5 * 16;
#pragma unroll
        for (int ks = 0; ks < 4; ++ks) {
            const bf16x8 bfr = ld_frag(rb + ks * 32);
#pragma unroll
            for (int m = 0; m < 2; ++m) acc[m] = mfma32(ld_frag(tb + m * 32 * 144 + ks * 32), bfr, acc[m]);
        }
        if (wid < 4) {
#pragma unroll
            for (int m = 0; m < 2; ++m) {
                uint4* up = (uint4*)(g_uf + ((size_t)(wid * 2 + m) * 64 + lane) * 16);
                up[0] = make_uint4(pack2(acc[m][0], acc[m][1]), pack2(acc[m][2], acc[m][3]), pack2(acc[m][4], acc[m][5]), pack2(acc[m][6], acc[m][7]));
                up[1] = make_uint4(pack2(acc[m][8], acc[m][9]), pack2(acc[m][10], acc[m][11]), pack2(acc[m][12], acc[m][13]), pack2(acc[m][14], acc[m][15]));
            }
        } else {
#pragma unroll
            for (int m = 0; m < 2; ++m)
#pragma unroll
                for (int i = 0; i < 16; ++i) g_negw[(32 * m + crow(i, h5)) * 128 + 32 * (wid - 4) + r] = f2bf(-acc[m][i]);
        }
    }
    __syncthreads();
}

DI void gla_shadow(const Params& P, char* lds, int U, int wq, int lane, const GlaIn& gi) {
    unsigned char* ub = P.ws + WS_GLA + (size_t)U * GLA_UNIT;
    u16* g_qe = (u16*)ub; u16* g_kdt = (u16*)(ub + 16384); float* g_dec = (float*)(ub + 24576);
    const float* gw = (const float*)(lds + PGL_W);
    const int d0 = 16 * wq;
    const float lr[16] = {gi.l[0].x, gi.l[0].y, gi.l[0].z, gi.l[0].w, gi.l[1].x, gi.l[1].y, gi.l[1].z, gi.l[1].w, gi.l[2].x, gi.l[2].y, gi.l[2].z, gi.l[2].w, gi.l[3].x, gi.l[3].y, gi.l[3].z, gi.l[3].w};
    const unsigned qw[8] = {gi.q[0].x, gi.q[0].y, gi.q[0].z, gi.q[0].w, gi.q[1].x, gi.q[1].y, gi.q[1].z, gi.q[1].w}, kw[8] = {gi.k[0].x, gi.k[0].y, gi.k[0].z, gi.k[0].w, gi.k[1].x, gi.k[1].y, gi.k[1].z, gi.k[1].w};
    unsigned qe[8], ke[8];
#pragma unroll
    for (int g4 = 0; g4 < 4; ++g4) {
        const float4 bz = *(const float4*)(gw + 1024 + d0 + 4 * g4);
        float z[4] = {bz.x, bz.y, bz.z, bz.w};
#pragma unroll
        for (int r = 0; r < 16; ++r) {
            const float4 wv = *(const float4*)(gw + r * 64 + d0 + 4 * g4);
            z[0] += lr[r] * wv.x; z[1] += lr[r] * wv.y; z[2] += lr[r] * wv.z; z[3] += lr[r] * wv.w;
        }
        float bb[4], blast[4];
#pragma unroll
        for (int e = 0; e < 4; ++e) bb[e] = (fminf(z[e], 0.f) - __logf(1.f + __expf(-fabsf(z[e])))) * 0.0625f;
#pragma unroll
        for (int e = 0; e < 4; ++e) bb[e] = wave_scan_incl(bb[e]);
#pragma unroll
        for (int e = 0; e < 4; ++e) blast[e] = __builtin_bit_cast(float, __builtin_amdgcn_readlane(__builtin_bit_cast(int, bb[e]), 63));
        float qev[4], kev[4];
#pragma unroll
        for (int e = 0; e < 4; ++e) {
            const int j = 4 * g4 + e, d = d0 + j;
            const float q = ((j & 1) ? bfhi(qw[j >> 1]) : bflo(qw[j >> 1])) * 0.125f, k = (j & 1) ? bfhi(kw[j >> 1]) : bflo(kw[j >> 1]);
            qev[e] = q * __expf(bb[e]); kev[e] = k * __expf(-bb[e]);
            g_kdt[d * 64 + lane] = f2bf(k * __expf(blast[e] - bb[e]));
            if (lane == 0) g_dec[d] = __expf(blast[e]);
        }
        qe[2 * g4] = pack2(qev[0], qev[1]); qe[2 * g4 + 1] = pack2(qev[2], qev[3]);
        ke[2 * g4] = pack2(kev[0], kev[1]); ke[2 * g4 + 1] = pack2(kev[2], kev[3]);
    }
    const uint4 qa = make_uint4(qe[0], qe[1], qe[2], qe[3]), qb = make_uint4(qe[4], qe[5], qe[6], qe[7]);
    *(uint4*)(lds + PGL_QE + lane * 144 + d0 * 2) = qa; *(uint4*)(lds + PGL_QE + lane * 144 + d0 * 2 + 16) = qb;
    *(uint4*)(lds + PGL_KE + lane * 144 + d0 * 2) = make_uint4(ke[0], ke[1], ke[2], ke[3]); *(uint4*)(lds + PGL_KE + lane * 144 + d0 * 2 + 16) = make_uint4(ke[4], ke[5], ke[6], ke[7]);
    *(uint4*)(g_qe + lane * 64 + d0) = qa; *(uint4*)(g_qe + lane * 64 + d0 + 8) = qb;
}
DI void gla_attn_tiles(const Params& P, char* lds, int U, int wid, int lane) {
    const int r = lane & 31, h5 = lane >> 5;
    u16* g_attn = (u16*)(P.ws + WS_GLA + (size_t)U * GLA_UNIT + 8192);
    const int ti = wid >> 1, tj = wid & 1;
    f32x16 acc;
#pragma unroll
    for (int i = 0; i < 16; ++i) acc[i] = 0.f;
    if (!(ti == 0 && tj == 1)) {
        const char* xa = lds + PGL_QE + (32 * ti + r) * 144 + h5 * 16;
        const char* xb = lds + PGL_KE + (32 * tj + r) * 144 + h5 * 16;
#pragma unroll
        for (int ks = 0; ks < 4; ++ks) acc = mfma32(ld_frag(xa + ks * 32), ld_frag(xb + ks * 32), acc);
    }
    const int j = 32 * tj + r;
#pragma unroll
    for (int i = 0; i < 16; ++i) {
        const int ii = 32 * ti + crow(i, h5);
        g_attn[ii * 64 + j] = f2bf((j <= ii) ? acc[i] : 0.f);
    }
}

DI void phase_prep(const Params& P, char* lds) {
    PrepPre pre;
    if ((int)blockIdx.x < 1024) prep_prefetch(P, blockIdx.x, threadIdx.x, pre);
    for (int u = blockIdx.x; u < 1024; u += gridDim.x) {
        const int un = u + (int)gridDim.x;
        gdn_prep_unit(P, lds, u, pre, un < 1024 ? un : -1);
    }
}

template <bool GDN> struct ScanCfg;
template <> struct ScanCfg<true>  { static constexpr int DK = 128, LDA = 264, NEGW = 0, QD = 16896, KDT = 33792, ATT = 51200, DEC = 0, STAGE = 59904; };
template <> struct ScanCfg<false> { static constexpr int DK = 64,  LDA = 136, NEGW = 0, QD = 0,     KDT = 8704,  ATT = 17408, DEC = 26112, STAGE = 26368; };
constexpr int SC_OST = 2 * 59904, SC_OSTB = 16896;

template <bool GDN>
DI void scan_stream(const Params& P, char* lds, int bh) {
    using C = ScanCfg<GDN>;
    constexpr int DK = C::DK, KT = DK / 32, KS = DK / 16;
    const int tid = threadIdx.x, lane = tid & 63, wid = tid >> 6, r = lane & 31, h5 = lane >> 5;
    const int hd = bh & 3, b = bh >> 2;
    const u16* proj = (const u16*)(P.ws + WS_PROJ);
    u16* mixed = (u16*)(P.ws + WS_MIXED);
    const int U0 = bh * 32;

    if (wid >= 4) {
        int ltv = tid - 256;
        asm volatile("" : "+v"(ltv));
        const int lt = ltv;
        const int epos = lt >> 2, eq = lt & 3;
        float* sgain = (float*)(lds + 153600);
        if (lt < 128) sgain[lt] = (GDN ? P.gdn_g : P.gla_g)[lt];
        const int gcol = (GDN ? C_ZB : C_RA) + hd * 128 + eq * 32;
        const int ocol = (GDN ? 512 : 0) + hd * 128 + eq * 32;
        constexpr int NV = GDN ? 14 : 6;
        u32x4 svA[NV], svB[NV]; float sdA = 0.f, sdB = 0.f; u32x4 gqA[4];
        const __amdgpu_buffer_rsrc_t rs_u = __builtin_amdgcn_make_buffer_rsrc((void*)(P.ws + (GDN ? WS_GDN : WS_GLA)), 0, (int)(1024 * (GDN ? GDN_UNIT : GLA_UNIT)), 0x00020000);
        const __amdgpu_buffer_rsrc_t rs_p = __builtin_amdgcn_make_buffer_rsrc((void*)(P.ws + WS_PROJ), 0, (int)((size_t)NTOK * PLD * 2), 0x00020000);
        int vo16 = lt * 16, vo4 = 24576 + lt * 4, vog = (epos * PLD + gcol) * 2;
        int o264 = (lt >> 4) * 264 + (lt & 15) * 16, o136 = (lt >> 3) * 136 + (lt & 7) * 16;
#define SC_LOADC(sv, sdv, cidx) do { const int ub_ = (U0 + (cidx)) * (int)(GDN ? GDN_UNIT : GLA_UNIT); \
            if (GDN) { \
                _Pragma("unroll") for (int q = 0; q < 4; ++q) sv[q] = __builtin_amdgcn_raw_buffer_load_b128(rs_u, vo16, ub_ + q * 4096, 0); \
                _Pragma("unroll") for (int q = 0; q < 4; ++q) sv[4 + q] = __builtin_amdgcn_raw_buffer_load_b128(rs_u, vo16, ub_ + 16384 + q * 4096, 0); \
                _Pragma("unroll") for (int q = 0; q < 4; ++q) sv[8 + q] = __builtin_amdgcn_raw_buffer_load_b128(rs_u, vo16, ub_ + 32768 + q * 4096, 0); \
                _Pragma("unroll") for (int q = 0; q < 2; ++q) sv[(GDN ? 12 : 0) + q] = __builtin_amdgcn_raw_buffer_load_b128(rs_u, vo16, ub_ + 49152 + q * 4096, 0); \
            } else { \
                _Pragma("unroll") for (int q = 0; q < 6; ++q) sv[q] = __builtin_amdgcn_raw_buffer_load_b128(rs_u, vo16, ub_ + q * 4096, 0); \
                if (lt < 64) sdv = __builtin_bit_cast(float, __builtin_amdgcn_raw_buffer_load_b32(rs_u, vo4, ub_, 0)); } \
            __builtin_amdgcn_sched_barrier(0); } while (0)
#define SC_W2(d, v) do { char* d_ = (d); *(uint2*)d_ = make_uint2((v).x, (v).y); *(uint2*)(d_ + 8) = make_uint2((v).z, (v).w); } while (0)
#define SC_WRITEC(sv, sdv, st) do { \
            if (GDN) { \
                _Pragma("unroll") for (int q = 0; q < 4; ++q) SC_W2((st) + C::NEGW + o264 + q * (16 * 264), sv[q]); \
                _Pragma("unroll") for (int q = 0; q < 4; ++q) SC_W2((st) + C::QD + o264 + q * (16 * 264), sv[4 + q]); \
                _Pragma("unroll") for (int q = 0; q < 4; ++q) SC_W2((st) + C::KDT + o136 + q * (32 * 136), sv[8 + q]); \
                _Pragma("unroll") for (int q = 0; q < 2; ++q) SC_W2((st) + C::ATT + o136 + q * (32 * 136), sv[(GDN ? 12 : 0) + q]); \
            } else { \
                _Pragma("unroll") for (int q = 0; q < 6; ++q) SC_W2((st) + ((q >> 1) == 0 ? C::QD : ((q >> 1) == 1 ? C::ATT : C::KDT)) + o136 + (q & 1) * (32 * 136), sv[q]); \
                if (lt < 64) *(float*)((st) + C::DEC + lt * 4) = sdv; } \
            __builtin_amdgcn_sched_barrier(0); } while (0)
#define SC_LOADG(gq, cidx) do { const int rb_ = (b * SEQ + (cidx) * 64) * (PLD * 2); \
            _Pragma("unroll") for (int q = 0; q < 4; ++q) gq[q] = __builtin_amdgcn_raw_buffer_load_b128(rs_p, vog, rb_ + q * 16, 0); \
            __builtin_amdgcn_sched_barrier(0); } while (0)
#define SC_EPI(gq, cidx) do { \
            const int t = b * SEQ + (cidx) * 64 + epos; \
            const char* orow = lds + SC_OST + ((cidx) & 1) * SC_OSTB + epos * 264 + eq * 64; \
            float ss = 0.f; \
            _Pragma("unroll") for (int q = 0; q < 8; ++q) { const uint2 x2 = *(const uint2*)(orow + q * 8); \
                const float a0 = bflo(x2.x), a1 = bfhi(x2.x), a2 = bflo(x2.y), a3 = bfhi(x2.y); ss += a0 * a0 + a1 * a1 + a2 * a2 + a3 * a3; } \
            ss += __shfl_xor(ss, 1, 64); ss += __shfl_xor(ss, 2, 64); \
            const float rstd = rsqrtf(ss * (1.f / 128.f) + 1e-6f); \
            __builtin_amdgcn_sched_barrier(0); \
            uint4* op = (uint4*)(mixed + (size_t)t * DM + ocol); \
            _Pragma("unroll") for (int g4 = 0; g4 < 4; ++g4) {        \
                const float4 gn0 = *(const float4*)(sgain + eq * 32 + g4 * 8), gn1 = *(const float4*)(sgain + eq * 32 + g4 * 8 + 4); \
                const uint2 oa = *(const uint2*)(orow + g4 * 16), ob = *(const uint2*)(orow + g4 * 16 + 8); \
                const unsigned z0 = gq[g4].x, z1 = gq[g4].y, z2 = gq[g4].z, z3 = gq[g4].w; \
                op[g4] = make_uint4(pack2(bflo(oa.x) * rstd * gn0.x * silu_f(bflo(z0)), bfhi(oa.x) * rstd * gn0.y * silu_f(bfhi(z0))), \
                                    pack2(bflo(oa.y) * rstd * gn0.z * silu_f(bflo(z1)), bfhi(oa.y) * rstd * gn0.w * silu_f(bfhi(z1))), \
                                    pack2(bflo(ob.x) * rstd * gn1.x * silu_f(bflo(z2)), bfhi(ob.x) * rstd * gn1.y * silu_f(bfhi(z2))), \
                                    pack2(bflo(ob.y) * rstd * gn1.z * silu_f(bflo(z3)), bfhi(ob.y) * rstd * gn1.w * silu_f(bfhi(z3)))); \
                __builtin_amdgcn_sched_barrier(0); } \
            } while (0)
        u32x4 gqB[4];
        SC_LOADC(svA, sdA, 0);
        SC_WRITEC(svA, sdA, lds);
        SC_LOADC(svB, sdB, 1);
        SC_LOADC(svA, sdA, 2);
        __syncthreads();
        for (int c = 0; c < NCH; c += 2) {
            asm volatile("" : "+v"(o264), "+v"(o136), "+v"(vo16), "+v"(vo4), "+v"(vog));
            SC_WRITEC(svB, sdB, lds + 59904);
            SC_LOADG(gqA, c);
            if (c + 3 < NCH) SC_LOADC(svB, sdB, c + 3);
            if (c > 0) SC_EPI(gqB, c - 1);
            __syncthreads();
            if (c + 2 < NCH) SC_WRITEC(svA, sdA, lds);
            SC_LOADG(gqB, c + 1);
            if (c + 4 < NCH) SC_LOADC(svA, sdA, c + 4);
            SC_EPI(gqA, c);
            __syncthreads();
        }
        SC_EPI(gqB, NCH - 1);
#undef SC_LOADC
#undef SC_W2
#undef SC_WRITEC
#undef SC_LOADG
#undef SC_EPI
    } else {
        int lnv = lane;
        asm volatile("" : "+v"(lnv));
        const int lane = lnv, r = lane & 31, h5 = lane >> 5;
        f32x16 S[KT];
        bf16x8 Sb[KS];
#pragma unroll
        for (int k = 0; k < KT; ++k)
#pragma unroll
            for (int i = 0; i < 16; ++i) S[k][i] = 0.f;
#pragma unroll
        for (int k = 0; k < KS; ++k) { u32x4 z = {0u, 0u, 0u, 0u}; Sb[k] = __builtin_bit_cast(bf16x8, z); }
        const float dlv = GDN ? ((const float*)(P.ws + WS_DL))[U0 + (lane & 31)] : 0.f;
        uint4 un[4];
        u16 vnx[32];
        auto fetch_uv = [&](int cidx) {
            if (GDN) {
                const uint4* up = (const uint4*)(P.ws + WS_GDN + (size_t)(U0 + cidx) * GDN_UNIT + 57344) + ((size_t)(wid * 2) * 64 + lane) * 2;
                un[0] = ldnt_u4(up); un[1] = ldnt_u4(up + 1); un[2] = ldnt_u4(up + 128); un[3] = ldnt_u4(up + 129);
            } else {
                const u16* vp = proj + (size_t)(b * SEQ + cidx * 64) * PLD + C_VA + hd * 128 + 32 * wid + r;
#pragma unroll
                for (int m = 0; m < 2; ++m)
#pragma unroll
                    for (int i = 0; i < 16; ++i) vnx[m * 16 + i] = vp[(size_t)(32 * m + crow(i, h5)) * PLD];
            }
        };
        fetch_uv(0);
        __syncthreads();
        constexpr int NOPS = GDN ? 56 : 24, N1 = GDN ? 32 : 8, N2 = N1 + 8;
        int rA = r * C::LDA + 8 * h5, r136 = r * 136 + 8 * h5;
#define SC_OFF(n) ((n) < N1 ? (GDN ? ((((n) & 1) ? C::QD : C::NEGW) + 32 * (((n) >> 1) & 1) * C::LDA + 32 * ((n) >> 2)) : (C::QD + 32 * ((n) & 1) * C::LDA + 32 * ((n) >> 1))) \
                  : ((n) < N2 ? (C::ATT + 32 * (((n) - N1) & 1) * 136 + 32 * (((n) - N1) >> 1)) : (C::KDT + 32 * (((n) - N2) >> 2) * 136 + 32 * (((n) - N2) & 3))))
#define SC_LDF(n) ld_frag2(st + SC_OFF(n) + ((n) < N1 ? rA : r136))
        for (int c = 0; c < NCH; ++c) {
            asm volatile("" : "+v"(rA), "+v"(r136));
            const char* st = lds + (c & 1) * 59904;
            bf16x8 fq[4];
#pragma unroll
            for (int n = 0; n < 4; ++n) fq[n] = SC_LDF(n);
            f32x16 vn[2];
            if (GDN) {
                const unsigned w0[8] = {un[0].x, un[0].y, un[0].z, un[0].w, un[1].x, un[1].y, un[1].z, un[1].w};
                const unsigned w1[8] = {un[2].x, un[2].y, un[2].z, un[2].w, un[3].x, un[3].y, un[3].z, un[3].w};
#pragma unroll
                for (int q = 0; q < 8; ++q) { vn[0][2 * q] = bflo(w0[q]); vn[0][2 * q + 1] = bfhi(w0[q]); vn[1][2 * q] = bflo(w1[q]); vn[1][2 * q + 1] = bfhi(w1[q]); }
            } else {
#pragma unroll
                for (int m = 0; m < 2; ++m)
#pragma unroll
                    for (int i = 0; i < 16; ++i) vn[m][i] = bf2f(vnx[m * 16 + i]);
            }
            if (c + 1 < NCH) fetch_uv(c + 1);
            const float dl = __builtin_bit_cast(float, __builtin_amdgcn_readlane(__builtin_bit_cast(int, dlv), c));
            f32x16 o[2];
#pragma unroll
            for (int m = 0; m < 2; ++m)
#pragma unroll
                for (int i = 0; i < 16; ++i) o[m][i] = 0.f;
            bf16x8 vb[4];
            if (!GDN) { vb[0] = pack8<0>(vn[0]); vb[1] = pack8<1>(vn[0]); vb[2] = pack8<0>(vn[1]); vb[3] = pack8<1>(vn[1]); }
            static_for<NOPS>([&](auto nc) {
                constexpr int n = decltype(nc)::value;
                const bf16x8 af = fq[n & 3];
                if constexpr (n + 4 < NOPS) fq[n & 3] = SC_LDF(n + 4);
                if constexpr (n < N1) {
                    if constexpr (GDN) {
                        constexpr int ks = n >> 2, m = (n >> 1) & 1;
                        if constexpr ((n & 1) == 0) vn[m] = mfma32(af, Sb[ks], vn[m]); else o[m] = mfma32(af, Sb[ks], o[m]);
                    } else {
                        constexpr int ks = n >> 1, m = n & 1;
                        o[m] = mfma32(af, Sb[ks], o[m]);
                    }
                } else if constexpr (n < N2) {
                    constexpr int ks = (n - N1) >> 1, m = (n - N1) & 1;
                    o[m] = mfma32(af, vb[ks], o[m]);
                } else {
                    constexpr int kt = (n - N2) >> 2, ks = (n - N2) & 3;
                    S[kt] = mfma32(af, vb[ks], S[kt]);
                }
                __builtin_amdgcn_sched_group_barrier(0x008, 1, 0);
                __builtin_amdgcn_sched_group_barrier(0x100, 2, 0);
                if constexpr (n == N1 - 1) {
                    if constexpr (GDN) { vb[0] = pack8<0>(vn[0]); vb[1] = pack8<1>(vn[0]); vb[2] = pack8<0>(vn[1]); vb[3] = pack8<1>(vn[1]); }
#pragma unroll
                    for (int k = 0; k < KT; ++k) {
                        if constexpr (GDN) {
#pragma unroll
                            for (int i = 0; i < 16; ++i) S[k][i] *= dl;
                        } else {
#pragma unroll
                            for (int q = 0; q < 4; ++q) {
                                const float4 dc = *(const float4*)(st + C::DEC + (32 * k + 8 * q + 4 * h5) * 4);
                                S[k][4 * q] *= dc.x; S[k][4 * q + 1] *= dc.y; S[k][4 * q + 2] *= dc.z; S[k][4 * q + 3] *= dc.w;
                            }
                        }
                    }
                }
            });
#pragma unroll
            for (int k = 0; k < KT; ++k) { Sb[2 * k] = pack8<0>(S[k]); Sb[2 * k + 1] = pack8<1>(S[k]); }
            char* ost = lds + SC_OST + (c & 1) * SC_OSTB;
#pragma unroll
            for (int m = 0; m < 2; ++m)
#pragma unroll
                for (int i = 0; i < 16; ++i) *(u16*)(ost + (32 * m + crow(i, h5)) * 264 + (32 * wid + r) * 2) = f2bf(o[m][i]);
            __syncthreads();
        }
#undef SC_OFF
#undef SC_LDF
    }
}

DI void phase_scan(const Params& P, char* lds) {
    const int wid = threadIdx.x >> 6;
    if (gridDim.x >= 128) {
        if (blockIdx.x < 64) { if (blockIdx.x < 32) scan_stream<true>(P, lds, blockIdx.x); else scan_stream<false>(P, lds, blockIdx.x - 32); }
        else convert_experts(P, (blockIdx.x - 64) * 8 + wid, (gridDim.x - 64) * 8);
    } else {
        for (int s = blockIdx.x; s < 64; s += gridDim.x) {
            if (s < 32) scan_stream<true>(P, lds, s); else scan_stream<false>(P, lds, s - 32);
            __syncthreads();
        }
        convert_experts(P, blockIdx.x * 8 + wid, gridDim.x * 8);
    }
}

struct EpiOutproj {
    u16* hbuf;
    DI void operator()(const pg::f32x4 (&acc)[2][2][4][2], const pg::DenseSched::Unit& u, int wr, int wc, int fr, int fq) const {
        const int row0 = u.pm * 256 + wr * 64 + fr, col0 = u.pn * 256 + wc * 32 + 8 * fq;
#pragma unroll
        for (int ai = 0; ai < 2; ++ai)
#pragma unroll
            for (int m = 0; m < 4; ++m) {
                u16* rowp = hbuf + (size_t)(row0 + ai * 128 + m * 16) * DM + col0;
#pragma unroll
                for (int bj = 0; bj < 2; ++bj) {
                    const pg::f32x4 v0 = acc[ai][bj][m][0], v1 = acc[ai][bj][m][1];
                    *(uint4*)(rowp + bj * 128) = make_uint4(pack2(v0[0], v0[1]), pack2(v0[2], v0[3]), pack2(v1[0], v1[1]), pack2(v1[2], v1[3]));
                }
            }
    }
};
DI void phase_outproj(const Params& P, char* lds) {
    pg::DenseSched S{(const char*)(P.ws + WS_MIXED), (const char*)(P.ws + WS_WOUTT), DM, 64, 4, (int)gridDim.x, (int)blockIdx.x};
    EpiOutproj E{(u16*)(P.ws + WS_HBUF)};
    pg::gemm_phase((LAS unsigned char*)lds, S, E, DM);
}

DI void phase_ln1_router(const Params& P, char* lds) {
    int tidv = threadIdx.x;
    asm volatile("" : "+v"(tidv));
    const int tid = tidv, lane = tid & 63, wid = __builtin_amdgcn_readfirstlane(tid >> 6);
    const u16* hbuf = (const u16*)(P.ws + WS_HBUF);
    float* x1f = (float*)(P.ws + WS_X1F);
    u16* x1b = (u16*)(P.ws + WS_X1B);
    const u16* wr_hi = (const u16*)(P.ws + WS_WRT); const u16* wr_lo = wr_hi + 80 * 1024;
    int* cnt = (int*)(P.ws + WS_CNT);
    int* ltok = (int*)(P.ws + WS_LTOK);
    float* lgate = (float*)(P.ws + WS_LGATE);
    float* part = (float*)lds;
    float* lg = (float*)(lds + 81920);
    int* rE1 = (int*)(lds + 102400); int* rE2 = rE1 + 64; int* rR1 = rE1 + 128; int* rR2 = rE1 + 192; int* hist = rE1 + 256; int* rbase = rE1 + 320;
    float* rG1 = (float*)(rE1 + 384); float* rG2 = rG1 + 64;
    for (int g = blockIdx.x; g < NTOK / 64; g += gridDim.x) {
        const int row0 = g * 64;
        if (tid < 64) hist[tid] = 0;
        uint2 hv[2][4]; float4 xv[2][4];
#define LN_FETCH(r_) do { _Pragma("unroll") for (int rr = 0; rr < 2; ++rr) { const size_t rb_ = (size_t)((r_) + rr) * DM + lane * 4; \
        _Pragma("unroll") for (int j = 0; j < 4; ++j) { { const u32x2_t hh = __builtin_nontemporal_load((const u32x2_t*)(hbuf + rb_ + 256 * j)); hv[rr][j] = make_uint2(hh.x, hh.y); } xv[rr][j] = ldnt4(P.x + rb_ + 256 * j); } } } while (0)
        LN_FETCH(row0 + wid * 8);
#pragma unroll 1
        for (int it = 0; it < 4; ++it) {
            float4 v[2][4];
#pragma unroll
            for (int rr = 0; rr < 2; ++rr)
#pragma unroll
                for (int j = 0; j < 4; ++j) v[rr][j] = make_float4(ALPHA * xv[rr][j].x + bflo(hv[rr][j].x), ALPHA * xv[rr][j].y + bfhi(hv[rr][j].x), ALPHA * xv[rr][j].z + bflo(hv[rr][j].y), ALPHA * xv[rr][j].w + bfhi(hv[rr][j].y));
            if (it < 3) LN_FETCH(row0 + wid * 8 + 2 * (it + 1));
#pragma unroll
            for (int rr = 0; rr < 2; ++rr) {
                const size_t rbase_ = (size_t)(row0 + wid * 8 + 2 * it + rr) * DM;
                float s = 0.f;
#pragma unroll
                for (int j = 0; j < 4; ++j) s += v[rr][j].x + v[rr][j].y + v[rr][j].z + v[rr][j].w;
                const float mu = wave_sum(s) * (1.f / 1024.f);
                float q = 0.f;
#pragma unroll
                for (int j = 0; j < 4; ++j) { const float a = v[rr][j].x - mu, b2 = v[rr][j].y - mu, c2 = v[rr][j].z - mu, d2 = v[rr][j].w - mu; q += a * a + b2 * b2 + c2 * c2 + d2 * d2; }
                const float rstd = rsqrtf(wave_sum(q) * (1.f / 1024.f) + 1e-5f);
#pragma unroll
                for (int j = 0; j < 4; ++j) {
                    const int col = lane * 4 + 256 * j;
                    const float4 gg = *(const float4*)(P.ln1_g + col), bb = *(const float4*)(P.ln1_b + col);
                    float4 o;
                    o.x = (v[rr][j].x - mu) * rstd * gg.x + bb.x; o.y = (v[rr][j].y - mu) * rstd * gg.y + bb.y;
                    o.z = (v[rr][j].z - mu) * rstd * gg.z + bb.z; o.w = (v[rr][j].w - mu) * rstd * gg.w + bb.w;
                    *(float4*)(x1f + rbase_ + col) = o;
                    *(uint2*)(x1b + rbase_ + col) = make_uint2(pack2(o.x, o.y), pack2(o.z, o.w));
                }
            }
        }
#undef LN_FETCH
        asm volatile("s_waitcnt vmcnt(0)" ::: "memory");
        __syncthreads();
        {
            f32x4 acc[2][5];
#pragma unroll
            for (int mt = 0; mt < 2; ++mt)
#pragma unroll
                for (int n = 0; n < 5; ++n) acc[mt][n] = f32x4{0.f, 0.f, 0.f, 0.f};
            const int mh = wid & 1, kq = wid >> 1, m = lane & 15, kg = lane >> 4;
            const float* ap = x1f + (size_t)(row0 + 32 * mh + m) * DM + 256 * kq + 8 * kg;
            const u16* bhp = wr_hi + (size_t)m * 1024 + 256 * kq + 8 * kg; const u16* blp = wr_lo + (size_t)m * 1024 + 256 * kq + 8 * kg;
#pragma unroll 2
            for (int ks = 0; ks < 8; ++ks) {
                bf16x8 bh[5], bl[5];
#pragma unroll
                for (int n = 0; n < 5; ++n) { bh[n] = ld_frag((const char*)(bhp + n * 16384 + 32 * ks)); bl[n] = ld_frag((const char*)(blp + n * 16384 + 32 * ks)); }
#pragma unroll
                for (int mt = 0; mt < 2; ++mt) {
                    const float4 f0 = *(const float4*)(ap + (size_t)mt * 16 * DM + 32 * ks), f1 = *(const float4*)(ap + (size_t)mt * 16 * DM + 32 * ks + 4);
                    const float f[8] = {f0.x, f0.y, f0.z, f0.w, f1.x, f1.y, f1.z, f1.w};
                    unsigned hi[4], lo[4];
#pragma unroll
                    for (int q = 0; q < 4; ++q) { hi[q] = pack2(f[2 * q], f[2 * q + 1]); lo[q] = pack2(f[2 * q] - bflo(hi[q]), f[2 * q + 1] - bfhi(hi[q])); }
                    const u32x4 hv4 = {hi[0], hi[1], hi[2], hi[3]}, lv4 = {lo[0], lo[1], lo[2], lo[3]};
                    const bf16x8 ah = __builtin_bit_cast(bf16x8, hv4), alo = __builtin_bit_cast(bf16x8, lv4);
#pragma unroll
                    for (int n = 0; n < 5; ++n) { acc[mt][n] = mfma16(ah, bh[n], acc[mt][n]); acc[mt][n] = mfma16(ah, bl[n], acc[mt][n]); acc[mt][n] = mfma16(alo, bh[n], acc[mt][n]); }
                }
            }
#pragma unroll
            for (int mt = 0; mt < 2; ++mt)
#pragma unroll
                for (int n = 0; n < 5; ++n)
#pragma unroll
                    for (int i = 0; i < 4; ++i) part[(kq * 64 + 32 * mh + 16 * mt + 4 * kg + i) * 80 + n * 16 + m] = acc[mt][n][i];
        }
        __syncthreads();
        for (int idx = tid; idx < 64 * 80; idx += 512) {
            const int cc = idx % 80;
            float s = part[idx] + part[5120 + idx] + part[10240 + idx] + part[15360 + idx];
            if (cc < 8) s += P.b_rg[cc]; else if (cc < 72) s += P.b_re[cc - 8];
            lg[idx] = s;
        }
        __syncthreads();
        if (tid < 64) {
            const float* L = lg + tid * 80;
            float mx = L[0]; int gs = 0;
#pragma unroll
            for (int q = 1; q < 8; ++q) { const float v = L[q]; if (v > mx) { mx = v; gs = q; } }
            float den = 0.f;
#pragma unroll
            for (int q = 0; q < 8; ++q) den += __expf(L[q] - mx);
            const float pgroup = 1.f / den;
            const float* E = L + 8 + gs * 8;
            float l1 = E[0]; int e1 = 0;
#pragma unroll
            for (int j = 1; j < 8; ++j) { const float v = E[j]; if (v > l1) { l1 = v; e1 = j; } }
            float l2 = -3.0e38f; int e2 = 0;
#pragma unroll
            for (int j = 0; j < 8; ++j) { const float v = E[j]; if (j != e1 && v > l2) { l2 = v; e2 = j; } }
            const float ex = __expf(l2 - l1);
            const float w1 = 1.f / (1.f + ex), w2 = ex / (1.f + ex);
            const int E1 = gs * 8 + e1, E2 = gs * 8 + e2;
            rE1[tid] = E1; rE2[tid] = E2; rG1[tid] = pgroup * w1; rG2[tid] = pgroup * w2;
            rR1[tid] = atomicAdd(&hist[E1], 1); rR2[tid] = atomicAdd(&hist[E2], 1);
        }
        __syncthreads();
        if (tid < 64) { const int h = hist[tid]; rbase[tid] = h > 0 ? atomicAdd(&cnt[tid], h) : 0; }
        __syncthreads();
        if (tid < 64) {
            const int E1 = rE1[tid], E2 = rE2[tid];
            const int p1 = rbase[E1] + rR1[tid], p2 = rbase[E2] + rR2[tid];
            ltok[E1 * 16384 + p1] = (row0 + tid) * 2; lgate[E1 * 16384 + p1] = rG1[tid];
            ltok[E2 * 16384 + p2] = (row0 + tid) * 2 + 1; lgate[E2 * 16384 + p2] = rG2[tid];
        }
        __syncthreads();
    }
}

constexpr int MOE_TAB = 131072, MOE_LIST = 131072 + 1024, MOE_ROWS = 131072 + 4096, MOE_GATE = MOE_ROWS + 8192;
DI int moe_build_table(const Params& P, char* lds) {
    int* tab = (int*)(lds + MOE_TAB); u16* plist = (u16*)(lds + MOE_LIST);
    const int* cnt = (const int*)(P.ws + WS_CNT);
    const int x = blockIdx.x & 7;
    if (threadIdx.x < 64) {
        const int e = threadIdx.x, c = cnt[e], nrb = (c + 255) >> 8;
        const bool mine = (e & 7) == x;
        const int tail = (mine && nrb > 0 && (c - (nrb - 1) * 256) <= 128) ? 1 : 0, full = mine ? nrb - tail : 0;
        const int ho_incl = (int)wave_scan_incl((float)(nrb * 256)), fu_incl = (int)wave_scan_incl((float)full), ta_incl = (int)wave_scan_incl((float)tail);
        const int nfull = __builtin_amdgcn_readlane(fu_incl, 63), ntail = __builtin_amdgcn_readlane(ta_incl, 63);
        tab[e] = c; tab[64 + e] = ho_incl - nrb * 256;
        const int p = fu_incl - full;
        for (int rb = 0; rb < full; ++rb) plist[p + rb] = (u16)((e << 8) | rb);
        if (tail) plist[nfull + ta_incl - 1] = (u16)((e << 8) | (nrb - 1));
        if (e == 0) tab[129] = nfull + ntail;
    }
    __syncthreads();
    return tab[129] * 4;
}
struct MoeSched {
    struct Unit { int e, rb, ns, slot, nvalid, hrow0; };
    static DI bool half1_empty(const Unit& u) { return u.nvalid <= 128; }
    const int* tab; const u16* plist; const int* rows;
    const char* A; const char* Bt; int nunits, G8, c8, base; bool down;
    DI bool next(int i, Unit& u) const {
        if (i >= 8) return false;
        const int L = (base + i) * G8 + c8; if (L >= nunits) return false;
        const int pr = plist[L >> 2];
        u.e = pr >> 8; u.rb = pr & 255; u.ns = L & 3; u.slot = i;
        u.nvalid = min(256, tab[u.e] - u.rb * 256); u.hrow0 = tab[64 + u.e] + u.rb * 256;
        return true;
    }
    DI void addr(const Unit& u, const int (&R)[2], const int (&C)[2], const char*& aBase, unsigned (&vA)[2][2], const char*& bBase) const {
        if (!down) {
            aBase = A; bBase = Bt + (size_t)(u.e * 4 + u.ns) * 256 * 1024 * 2;
#pragma unroll
            for (int h = 0; h < 2; ++h)
#pragma unroll
                for (int i = 0; i < 2; ++i) vA[h][i] = (unsigned)(rows[u.slot * 256 + h * 128 + R[i]] * 1024 + C[i]) * 2u;
        } else {
            aBase = A + (size_t)u.hrow0 * 512 * 2; bBase = Bt + ((size_t)u.e * 1024 + u.ns * 256) * 512 * 2;
#pragma unroll
            for (int h = 0; h < 2; ++h)
#pragma unroll
                for (int i = 0; i < 2; ++i) vA[h][i] = (unsigned)((h * 128 + R[i]) * 512 + C[i]) * 2u;
        }
    }
};
struct EpiMoeUp {
    u16* H;
    DI void operator()(const pg::f32x4 (&acc)[2][2][4][2], const MoeSched::Unit& u, int wr, int wc, int fr, int fq) const {
        const int col0 = u.ns * 128 + wc * 32 + 8 * fq;
#pragma unroll
        for (int ai = 0; ai < 2; ++ai)
#pragma unroll
            for (int m = 0; m < 4; ++m) {
                const int rl = ai * 128 + wr * 64 + m * 16 + fr;
                if (rl < u.nvalid) {
                    const pg::f32x4 g0 = acc[ai][0][m][0], g1 = acc[ai][0][m][1], u0 = acc[ai][1][m][0], u1 = acc[ai][1][m][1];
                    *(uint4*)(H + (size_t)(u.hrow0 + rl) * 512 + col0) =
                        make_uint4(pack2(silu_f(g0[0]) * u0[0], silu_f(g0[1]) * u0[1]), pack2(silu_f(g0[2]) * u0[2], silu_f(g0[3]) * u0[3]),
                                   pack2(silu_f(g1[0]) * u1[0], silu_f(g1[1]) * u1[1]), pack2(silu_f(g1[2]) * u1[2], silu_f(g1[3]) * u1[3]));
                }
            }
    }
};
struct EpiMoeDown {
    u16* ys; const int* meta; const float* gate;
    DI void operator()(const pg::f32x4 (&acc)[2][2][4][2], const MoeSched::Unit& u, int wr, int wc, int fr, int fq) const {
        const int col0 = u.ns * 256 + wc * 32 + 8 * fq;
#pragma unroll
        for (int ai = 0; ai < 2; ++ai)
#pragma unroll
            for (int m = 0; m < 4; ++m) {
                const int rl = ai * 128 + wr * 64 + m * 16 + fr;
                const int mt = meta[u.slot * 256 + rl]; const float gt = gate[u.slot * 256 + rl];
                if (mt >= 0) {
                    u16* dst = ys + ((size_t)(mt & 1) * NTOK + (mt >> 1)) * DM + col0;
#pragma unroll
                    for (int bj = 0; bj < 2; ++bj) {
                        const pg::f32x4 v0 = acc[ai][bj][m][0], v1 = acc[ai][bj][m][1];
                        *(uint4*)(dst + bj * 128) = make_uint4(pack2(gt * v0[0], gt * v0[1]), pack2(gt * v0[2], gt * v0[3]), pack2(gt * v1[0], gt * v1[1]), pack2(gt * v1[2], gt * v1[3]));
                    }
                }
            }
    }
};
DI void phase_moe(const Params& P, char* lds, bool down) {
    const int tid = threadIdx.x;
    const int nunits = moe_build_table(P, lds);
    const int* tab = (const int*)(lds + MOE_TAB);
    int* rows = (int*)(lds + MOE_ROWS); float* gts = (float*)(lds + MOE_GATE);
    const int* ltok = (const int*)(P.ws + WS_LTOK);
    const float* lgate = (const float*)(P.ws + WS_LGATE);
    const int G8 = gridDim.x >> 3, c8 = blockIdx.x >> 3;
    for (int base = 0; base * G8 + c8 < nunits; base += 8) {
        MoeSched S{tab, (const u16*)(lds + MOE_LIST), rows, down ? (const char*)(P.ws + WS_H) : (const char*)(P.ws + WS_X1B), down ? (const char*)(P.ws + WS_WD) : (const char*)(P.ws + WS_WGU), nunits, G8, c8, base, down};
        for (int i = 0; i < 8; ++i) {
            MoeSched::Unit u;
            if (!S.next(i, u)) break;
            if (tid < 256) {
                const bool ok = tid < u.nvalid;
                const int mt = ok ? ltok[u.e * 16384 + u.rb * 256 + tid] : -1;
                rows[i * 256 + tid] = down ? mt : (ok ? (mt >> 1) : 0);
                if (down) gts[i * 256 + tid] = ok ? lgate[u.e * 16384 + u.rb * 256 + tid] : 0.f;
            }
        }
        __syncthreads();
        if (!down) { EpiMoeUp E{(u16*)(P.ws + WS_H)}; pg::gemm_phase((LAS unsigned char*)lds, S, E, 1024); }
        else { EpiMoeDown E{(u16*)(P.ws + WS_YS), rows, gts}; pg::gemm_phase((LAS unsigned char*)lds, S, E, 512); }
        __syncthreads();
    }
}

DI void phase_ln2(const Params& P) {
    const int tid = threadIdx.x, lane = tid & 63, wid = tid >> 6;
    const float* x1f = (const float*)(P.ws + WS_X1F);
    const u16* ys = (const u16*)(P.ws + WS_YS);
    for (int row = blockIdx.x * 8 + wid; row < NTOK; row += gridDim.x * 8) {
        const size_t rbase = (size_t)row * DM;
        float4 v[4];
#pragma unroll
        for (int j = 0; j < 4; ++j) {
            const int col = lane * 4 + 256 * j;
            const float4 xv = ldnt4(x1f + rbase + col);
            const uint2 a = *(const uint2*)(ys + rbase + col), b2 = *(const uint2*)(ys + (size_t)NTOK * DM + rbase + col);
            v[j].x = ALPHA * xv.x + bflo(a.x) + bflo(b2.x); v[j].y = ALPHA * xv.y + bfhi(a.x) + bfhi(b2.x);
            v[j].z = ALPHA * xv.z + bflo(a.y) + bflo(b2.y); v[j].w = ALPHA * xv.w + bfhi(a.y) + bfhi(b2.y);
        }
        float s = 0.f;
#pragma unroll
        for (int j = 0; j < 4; ++j) s += v[j].x + v[j].y + v[j].z + v[j].w;
        const float mu = wave_sum(s) * (1.f / 1024.f);
        float q = 0.f;
#pragma unroll
        for (int j = 0; j < 4; ++j) { const float a = v[j].x - mu, b2 = v[j].y - mu, c2 = v[j].z - mu, d2 = v[j].w - mu; q += a * a + b2 * b2 + c2 * c2 + d2 * d2; }
        const float rstd = rsqrtf(wave_sum(q) * (1.f / 1024.f) + 1e-5f);
#pragma unroll
        for (int j = 0; j < 4; ++j) {
            const int col = lane * 4 + 256 * j;
            const float4 g = *(const float4*)(P.ln2_g + col), bb = *(const float4*)(P.ln2_b + col);
            float4 o;
            o.x = (v[j].x - mu) * rstd * g.x + bb.x; o.y = (v[j].y - mu) * rstd * g.y + bb.y;
            o.z = (v[j].z - mu) * rstd * g.z + bb.z; o.w = (v[j].w - mu) * rstd * g.w + bb.w;
            stnt4(P.out + rbase + col, o);
        }
    }
}

__global__ void __launch_bounds__(512, 2) fwd_kernel(Params P) {
    extern __shared__ __attribute__((aligned(16))) char lds[];
    volatile LAS unsigned* xbw = (volatile LAS unsigned*)(lds + LDS_BYTES - 16);
    const int lo = P.ph_lo, hi = P.ph_hi;
    XcdBarrier bar;
    if (hi - lo > 1) {
        if (threadIdx.x == 0) { xbw[0] = 0u; xbw[1] = 0u; xbw[2] = 0u; xbw[3] = 0u; }
        __syncthreads();
        bar = xcd_barrier_post((unsigned*)(P.ws + WS_BAR), xbw);
    }
#define IN(k) (lo <= (k) && (k) < hi)
#define SEAM(k) do { if (IN(k) && IN((k) + 1)) xcd_barrier(bar); } while (0)
#define RUN(k, call) do { if (IN(k)) { call; if (REPEAT_PHASE == (k)) { xcd_barrier(bar); \
        if ((k) == 5) { if (blockIdx.x == 0 && threadIdx.x < 64) ((int*)(P.ws + WS_CNT))[threadIdx.x] = 0; xcd_barrier(bar); } call; } } } while (0)
    RUN(0, phase_convert(P));
    SEAM(0);
    RUN(1, phase_inproj(P, lds));
    SEAM(1);
    RUN(2, phase_prep(P, lds));
    SEAM(2);
    RUN(3, phase_scan(P, lds));
    SEAM(3);
    RUN(4, phase_outproj(P, lds));
    SEAM(4);
    RUN(5, phase_ln1_router(P, lds));
    SEAM(5);
    RUN(6, phase_moe(P, lds, false));
    SEAM(6);
    RUN(7, phase_moe(P, lds, true));
    SEAM(7);
    RUN(8, phase_ln2(P));
#undef RUN
#undef IN
#undef SEAM
}

extern "C" void kernel_launch(void* const* d_in, const int* in_sizes, int n_in, void* d_out, int out_size, void* d_ws, size_t ws_size, hipStream_t stream) {
    static int grid = 0;
    if (grid == 0) {
        if (n_in != 21 || in_sizes[0] != NTOK * DM || out_size != NTOK * DM || ws_size < WS_END) {
            fprintf(stderr, "kernel_launch: unexpected shapes (n_in %d, in0 %d, out %d, ws %zu); nothing launched\n", n_in, n_in > 0 ? in_sizes[0] : -1, out_size, ws_size);
            grid = -1; return;
        }
        int dev = 0, cus = 0;
        if (hipGetDevice(&dev) != hipSuccess || hipDeviceGetAttribute(&cus, hipDeviceAttributeMultiprocessorCount, dev) != hipSuccess) { grid = -1; return; }
        if (hipFuncSetAttribute((const void*)fwd_kernel, hipFuncAttributeMaxDynamicSharedMemorySize, LDS_BYTES) != hipSuccess) { fprintf(stderr, "kernel_launch: hipFuncSetAttribute failed\n"); grid = -1; return; }
        int per_cu = 0;
        if (hipOccupancyMaxActiveBlocksPerMultiprocessor(&per_cu, (const void*)fwd_kernel, 512, LDS_BYTES) != hipSuccess || per_cu < 1)
            fprintf(stderr, "kernel_launch: occupancy query reports %d blocks per CU\n", per_cu);
        (void)hipGetLastError();
        grid = cus & ~7;
    }
    if (grid < 0) return;
    (void)hipMemsetAsync(d_ws, 0, 16384 + 1024, stream);
    Params p{};
    const float** pf = (const float**)&p;
    for (int i = 0; i < 21; ++i) pf[i] = (const float*)d_in[i];
    p.out = (float*)d_out; p.ws = (unsigned char*)d_ws;
#if MK_N_LAUNCHES == 1
    p.ph_lo = 0; p.ph_hi = NPHASE;
    hipLaunchKernelGGL(fwd_kernel, dim3(grid), dim3(512), LDS_BYTES, stream, p);
#else
    for (int k = 0; k < NPHASE; ++k) {
        p.ph_lo = k; p.ph_hi = k + 1;
        hipLaunchKernelGGL(fwd_kernel, dim3(grid), dim3(512), LDS_BYTES, stream, p);
    }
#endif
}
```
